# Optimizing an MI355X kernel written in HIP

```python
import math
import jax, jax.numpy as jnp
from jax import lax
import numpy as np

D_MODEL = 1024
BATCH = 1
SEQ = 16384
DEPTH = 2

NORM_EPS = 1e-6
CONV_K = 4
ATTN_HEADS = 8
ATTN_HEAD_DIM = 64
ATTN_WIDTH = ATTN_HEADS * ATTN_HEAD_DIM
DILATED_PATTERNS = ((128, 1), (512, 4), (2048, 16))
ATTN_BLOCK = 128
LRU_WIDTH = D_MODEL // 2
LRU_BLOCKS = 8
LRU_C = 8.0
AB_IN = 3 * ATTN_WIDTH + 2 * LRU_WIDTH
DN_HEADS = 8
DN_HEAD_DIM = 128
DN_WIDTH = DN_HEADS * DN_HEAD_DIM
DN_CHUNK = 64
DN_IN = 4 * DN_WIDTH + 2 * DN_HEADS
XA_HEADS = 4
XA_HEAD_DIM = D_MODEL // XA_HEADS
N_MEM = 256
D_FF = ((8 * D_MODEL // 3 + 127) // 128) * 128

kernel_name = "hybrid_dilated_attn_rglru_gdn_macaron"


def rmsnorm(x, g):
    xf = x.astype(jnp.float32)
    y = xf * lax.rsqrt(jnp.mean(xf * xf, axis=-1, keepdims=True) + NORM_EPS)
    return (y * g.astype(jnp.float32)).astype(x.dtype)


def swiglu(h, w_in, w_out):
    gate, up = jnp.split(h @ w_in, 2, axis=-1)
    return (jax.nn.silu(gate) * up) @ w_out


def causal_dwconv(x, w):
    C = x.shape[-1]
    return lax.conv_general_dilated(
        x, w[:, None, :].astype(x.dtype), window_strides=(1,),
        padding=((w.shape[0] - 1, 0),), dimension_numbers=('NWC', 'WIO', 'NWC'),
        feature_group_count=C)


def dilated_window_attention(q, k, v, dilation, n_back):
    B, S, H, hd = q.shape
    L = S // dilation
    Bd = B * dilation
    Lp = -(-L // ATTN_BLOCK) * ATTN_BLOCK
    nb = Lp // ATTN_BLOCK

    def split(t):
        t = t.reshape(B, L, dilation, H, hd).transpose(0, 2, 1, 3, 4).reshape(Bd, L, H, hd)
        return jnp.pad(t, ((0, 0), (0, Lp - L), (0, 0), (0, 0))).reshape(Bd, nb, ATTN_BLOCK, H, hd)

    qb, kb, vb = split(q), split(k), split(v)

    def with_prev(t):
        prev = jnp.concatenate([jnp.zeros_like(t[:, :1]), t[:, :-1]], axis=1)
        return jnp.concatenate([prev, t], axis=2)

    kk, vv = with_prev(kb), with_prev(vb)
    s = jnp.einsum('bnqhd,bnkhd->bnhqk', qb, kk).astype(jnp.float32) * (hd ** -0.5)
    qi = jnp.arange(ATTN_BLOCK)[:, None]
    kj = jnp.arange(2 * ATTN_BLOCK)[None, :]
    dist = qi + ATTN_BLOCK - kj
    band = (dist >= 0) & (dist <= n_back)
    not_first = (jnp.arange(nb) > 0)[:, None, None] | (kj >= ATTN_BLOCK)[None]
    valid = band[None] & not_first
    s = jnp.where(valid[None, :, None], s, -jnp.inf)
    m = jnp.max(s, axis=-1, keepdims=True)
    p = jnp.exp(s - m)
    den = jnp.sum(p, axis=-1)
    o = jnp.einsum('bnhqk,bnkhd->bnqhd', p, vv.astype(jnp.float32))
    den_t = jnp.moveaxis(den, 2, 3)
    o = o / den_t[..., None]
    lse = jnp.moveaxis(m[..., 0], 2, 3) + jnp.log(den_t)
    o = o.reshape(Bd, Lp, H, hd)[:, :L].reshape(B, dilation, L, H, hd).transpose(0, 2, 1, 3, 4)
    lse = lse.reshape(Bd, Lp, H)[:, :L].reshape(B, dilation, L, H).transpose(0, 2, 1, 3)
    return o.reshape(B, S, H, hd), lse.reshape(B, S, H)


def linear_scan(a, b):
    def comb(l, r):
        return (l[0] * r[0], r[0] * l[1] + r[1])
    _, h = lax.associative_scan(comb, (a, b), axis=1)
    return h


def attn_lru_mixer(h, w_in, conv_w, conv_b, w_a, b_a, w_x, b_x, lam, w_out):
    B, S, _ = h.shape
    A = ATTN_WIDTH
    q, k, v, xr, gr = jnp.split(h @ w_in, [A, 2 * A, 3 * A, 3 * A + LRU_WIDTH], axis=-1)
    shp = (B, S, ATTN_HEADS, ATTN_HEAD_DIM)
    q, k, v = q.reshape(shp), k.reshape(shp), v.reshape(shp)
    outs, lses = [], []
    for window, dil in DILATED_PATTERNS:
        o, l = dilated_window_attention(q, k, v, dil, window // dil)
        outs.append(o)
        lses.append(l)
    wts = jax.nn.softmax(jnp.stack(lses, 0), axis=0)
    attn = jnp.einsum('gbsh,gbshd->bshd', wts, jnp.stack(outs, 0))
    attn = attn.reshape(B, S, A).astype(h.dtype)
    xc = (causal_dwconv(xr, conv_w) + conv_b).astype(jnp.float32)
    xb = xc.reshape(B, S, LRU_BLOCKS, LRU_WIDTH // LRU_BLOCKS)
    r = jax.nn.sigmoid(jnp.einsum('bsnj,njk->bsnk', xb, w_a.astype(jnp.float32)).reshape(B, S, LRU_WIDTH)
                       + b_a.astype(jnp.float32))
    i = jax.nn.sigmoid(jnp.einsum('bsnj,njk->bsnk', xb, w_x.astype(jnp.float32)).reshape(B, S, LRU_WIDTH)
                       + b_x.astype(jnp.float32))
    log_a = -LRU_C * r * jax.nn.softplus(-lam.astype(jnp.float32))
    a = jnp.exp(log_a)
    mult = jnp.sqrt(-jnp.expm1(2.0 * log_a))
    hs = linear_scan(a, mult * i * xc)
    y = hs.astype(h.dtype) * jax.nn.gelu(gr)
    return jnp.concatenate([attn, y], axis=-1) @ w_out


def l2norm(t):
    return t * lax.rsqrt(jnp.sum(t * t, axis=-1, keepdims=True) + 1e-6)


def gated_delta_rule_chunked(q, k, v, g, beta):
    B, S, H, dk = q.shape
    dv = v.shape[-1]
    C = DN_CHUNK
    N = S // C

    def ch(t):
        t = jnp.moveaxis(t, 2, 1)
        return t.reshape((B, H, N, C) + t.shape[3:])

    q = ch(q * (dk ** -0.5))
    k, v, g, beta = ch(k), ch(v), ch(g), ch(beta)
    gcum = jnp.cumsum(g, axis=-1)
    tril = jnp.tril(jnp.ones((C, C), bool))
    strict = jnp.tril(jnp.ones((C, C), bool), -1)
    decay = jnp.exp(jnp.where(tril, gcum[..., :, None] - gcum[..., None, :], -jnp.inf))
    kb = k * beta[..., None]
    kkt = jnp.einsum('bhnid,bhnjd->bhnij', kb, k) * decay
    amat = jnp.eye(C, dtype=jnp.float32) + jnp.where(strict, kkt, 0.0)
    rhs = jnp.concatenate([v * beta[..., None], kb * jnp.exp(gcum)[..., None]], axis=-1)
    sol = lax.linalg.triangular_solve(amat, rhs, left_side=True, lower=True, unit_diagonal=True)
    u, w = sol[..., :dv], sol[..., dv:]
    qk = jnp.einsum('bhnid,bhnjd->bhnij', q, k) * decay

    def step(state, inp):
        q_i, k_i, u_i, w_i, qk_i, g_i = inp
        v_new = u_i - jnp.einsum('bhcd,bhde->bhce', w_i, state)
        o = (jnp.einsum('bhcd,bhde->bhce', q_i * jnp.exp(g_i)[..., None], state)
             + jnp.einsum('bhij,bhje->bhie', qk_i, v_new))
        g_last = g_i[..., -1]
        state = (state * jnp.exp(g_last)[..., None, None]
                 + jnp.einsum('bhcd,bhce->bhde', k_i * jnp.exp(g_last[..., None] - g_i)[..., None], v_new))
        return state, o

    xs = tuple(jnp.moveaxis(t, 2, 0) for t in (q, k, u, w, qk, gcum))
    state0 = jnp.zeros((B, H, dk, dv), jnp.float32)
    _, o = lax.scan(step, state0, xs)
    o = jnp.transpose(o, (1, 0, 3, 2, 4)).reshape(B, S, H, dv)
    return o


def deltanet_mixer(h, w_in, conv_w, a_log, dt_bias, o_norm, w_out):
    B, S, _ = h.shape
    W = DN_WIDTH
    qkv, z, a, b = jnp.split(h @ w_in, [3 * W, 4 * W, 4 * W + DN_HEADS], axis=-1)
    qkv = jax.nn.silu(causal_dwconv(qkv, conv_w)).astype(jnp.float32)
    q, k, v = jnp.split(qkv, 3, axis=-1)
    shp = (B, S, DN_HEADS, DN_HEAD_DIM)
    q, k, v = l2norm(q.reshape(shp)), l2norm(k.reshape(shp)), v.reshape(shp)
    beta = jax.nn.sigmoid(b.astype(jnp.float32))
    g = -jnp.exp(a_log.astype(jnp.float32)) * jax.nn.softplus(a.astype(jnp.float32) + dt_bias.astype(jnp.float32))
    o = gated_delta_rule_chunked(q, k, v, g, beta)
    o = rmsnorm(o, o_norm) * jax.nn.silu(z.reshape(shp).astype(jnp.float32))
    return o.reshape(B, S, W).astype(h.dtype) @ w_out


def cross_attention(h, mem_h, wq, wkv, wo):
    B, S, _ = h.shape
    M = mem_h.shape[1]
    q = (h @ wq).reshape(B, S, XA_HEADS, XA_HEAD_DIM)
    k, v = jnp.split(mem_h @ wkv, 2, axis=-1)
    k = k.reshape(B, M, XA_HEADS, XA_HEAD_DIM)
    v = v.reshape(B, M, XA_HEADS, XA_HEAD_DIM)
    s = jnp.einsum('bshd,bmhd->bhsm', q, k).astype(jnp.float32) * (XA_HEAD_DIM ** -0.5)
    p = jax.nn.softmax(s, axis=-1).astype(v.dtype)
    o = jnp.einsum('bhsm,bmhd->bshd', p, v).reshape(B, S, D_MODEL)
    return o @ wo


def setup_inputs(seed: int = 0) -> dict:
    key = jax.random.key(seed)
    keys = iter(jax.random.split(key, 64))
    n_even = (DEPTH + 1) // 2
    n_odd = DEPTH // 2
    f32 = jnp.float32

    def nrm(shape, fan_in):
        return jax.random.normal(next(keys), shape, f32) * (fan_in ** -0.5)

    def gain(shape):
        return 1.0 + 0.02 * jax.random.normal(next(keys), shape, f32)

    def small(shape):
        return 0.01 * jax.random.normal(next(keys), shape, f32)

    x = jax.random.normal(next(keys), (BATCH, SEQ, D_MODEL), f32)
    mem = jax.random.normal(next(keys), (BATCH, N_MEM, D_MODEL), f32)
    blk = LRU_WIDTH // LRU_BLOCKS
    a0 = jax.random.uniform(next(keys), (n_even, LRU_WIDTH), f32, 0.9, 0.999)
    a_base = a0 ** (1.0 / LRU_C)
    lam = jnp.log(a_base) - jnp.log1p(-a_base)
    dt = jnp.exp(jax.random.uniform(next(keys), (n_odd, DN_HEADS), f32, math.log(1e-3), math.log(0.1)))
    dt_bias = dt + jnp.log(-jnp.expm1(-dt))
    a_log = jnp.log(jax.random.uniform(next(keys), (n_odd, DN_HEADS), f32, 1.0, 16.0))
    return {
        "x": x,
        "mem": mem,
        "ffn1_norm": gain((DEPTH, D_MODEL)),
        "ffn1_w_in": nrm((DEPTH, D_MODEL, 2 * D_FF), D_MODEL),
        "ffn1_w_out": nrm((DEPTH, D_FF, D_MODEL), D_FF),
        "mix_norm": gain((DEPTH, D_MODEL)),
        "xa_norm": gain((DEPTH, D_MODEL)),
        "xa_mem_norm": gain((DEPTH, D_MODEL)),
        "xa_wq": nrm((DEPTH, D_MODEL, D_MODEL), D_MODEL),
        "xa_wkv": nrm((DEPTH, D_MODEL, 2 * D_MODEL), D_MODEL),
        "xa_wo": nrm((DEPTH, D_MODEL, D_MODEL), D_MODEL),
        "ffn2_norm": gain((DEPTH, D_MODEL)),
        "ffn2_w_in": nrm((DEPTH, D_MODEL, 2 * D_FF), D_MODEL),
        "ffn2_w_out": nrm((DEPTH, D_FF, D_MODEL), D_FF),
        "ab_w_in": nrm((n_even, D_MODEL, AB_IN), D_MODEL),
        "lru_conv_w": nrm((n_even, CONV_K, LRU_WIDTH), CONV_K),
        "lru_conv_b": small((n_even, LRU_WIDTH)),
        "lru_w_a": nrm((n_even, LRU_BLOCKS, blk, blk), blk),
        "lru_b_a": small((n_even, LRU_WIDTH)),
        "lru_w_x": nrm((n_even, LRU_BLOCKS, blk, blk), blk),
        "lru_b_x": small((n_even, LRU_WIDTH)),
        "lru_lambda": lam,
        "ab_w_out": nrm((n_even, ATTN_WIDTH + LRU_WIDTH, D_MODEL), ATTN_WIDTH + LRU_WIDTH),
        "dn_w_in": nrm((n_odd, D_MODEL, DN_IN), D_MODEL),
        "dn_conv_w": nrm((n_odd, CONV_K, 3 * DN_WIDTH), CONV_K),
        "dn_a_log": a_log,
        "dn_dt_bias": dt_bias,
        "dn_o_norm": gain((n_odd, DN_HEAD_DIM)),
        "dn_w_out": nrm((n_odd, DN_WIDTH, D_MODEL), DN_WIDTH),
        "final_norm": gain((D_MODEL,)),
    }


def reference(x, mem, ffn1_norm, ffn1_w_in, ffn1_w_out, mix_norm, xa_norm, xa_mem_norm,
              xa_wq, xa_wkv, xa_wo, ffn2_norm, ffn2_w_in, ffn2_w_out,
              ab_w_in, lru_conv_w, lru_conv_b, lru_w_a, lru_b_a, lru_w_x, lru_b_x, lru_lambda, ab_w_out,
              dn_w_in, dn_conv_w, dn_a_log, dn_dt_bias, dn_o_norm, dn_w_out, final_norm):
    for layer in range(DEPTH):
        x = x + 0.5 * swiglu(rmsnorm(x, ffn1_norm[layer]), ffn1_w_in[layer], ffn1_w_out[layer])
        h = rmsnorm(x, mix_norm[layer])
        j = layer // 2
        if layer % 2 == 0:
            x = x + attn_lru_mixer(h, ab_w_in[j], lru_conv_w[j], lru_conv_b[j], lru_w_a[j], lru_b_a[j],
                                   lru_w_x[j], lru_b_x[j], lru_lambda[j], ab_w_out[j])
        else:
            x = x + deltanet_mixer(h, dn_w_in[j], dn_conv_w[j], dn_a_log[j], dn_dt_bias[j],
                                   dn_o_norm[j], dn_w_out[j])
        x = x + cross_attention(rmsnorm(x, xa_norm[layer]), rmsnorm(mem, xa_mem_norm[layer]),
                                xa_wq[layer], xa_wkv[layer], xa_wo[layer])
        x = x + 0.5 * swiglu(rmsnorm(x, ffn2_norm[layer]), ffn2_w_in[layer], ffn2_w_out[layer])
    return rmsnorm(x, final_norm)
```

```cpp
#include <hip/hip_runtime.h>
#include <hip/hip_cooperative_groups.h>
#include <cstdio>
#include <cstdint>
namespace cg = cooperative_groups;

#define LAS __attribute__((address_space(3)))
typedef unsigned short bf16;
typedef short bf16x8 __attribute__((ext_vector_type(8)));
typedef short s16x4 __attribute__((ext_vector_type(4)));
typedef float f32x4 __attribute__((ext_vector_type(4)));
typedef float f32x2 __attribute__((ext_vector_type(2)));
typedef unsigned u32x4 __attribute__((ext_vector_type(4)));
typedef unsigned u32x2 __attribute__((ext_vector_type(2)));
typedef __bf16 bf16x2_t __attribute__((ext_vector_type(2)));

constexpr int S = 16384, D = 1024, FF = 2816, NMEM = 256;
constexpr int ABN = 2560, DNN = 4352, DNREAL = 4112, QKVW = 3072;
constexpr float EPS = 1e-6f;
constexpr size_t MiB = 1u << 20;
constexpr size_t WS_SSQ = 1 * MiB;
constexpr size_t WS_DNAB = 2 * MiB;
constexpr size_t WS_MEMB = 3 * MiB;
constexpr size_t WS_MEMRS = 3 * MiB + 512 * 1024;
constexpr size_t WS_DECAY = 3 * MiB + 768 * 1024;
constexpr size_t WS_LRUTOT = 4 * MiB;
constexpr size_t WS_HALO = 5 * MiB;
constexpr size_t WS_KV = 10 * MiB;
constexpr size_t WS_WQK = 12 * MiB;
constexpr size_t WS_WVO = 16 * MiB;
constexpr size_t WS_F1IN = 20 * MiB, WS_F1OUT = 31 * MiB, WS_F2IN = WS_F1OUT + 5 * MiB + 512 * 1024, WS_F2OUT = WS_F2IN + 11 * MiB;
constexpr size_t WS_MIXIN = 53 * MiB, WS_MIXOUT = WS_MIXIN + 8 * MiB + 512 * 1024;
constexpr size_t WS_XB = 64 * MiB;
constexpr size_t WS_OB = 96 * MiB;
constexpr size_t WS_BIG = 128 * MiB;
constexpr size_t WS_END = 256 * MiB;
static_assert(WS_F2OUT + 5 * MiB + 512 * 1024 <= WS_MIXIN && WS_MIXOUT + 2 * MiB <= WS_XB, "weights map");

constexpr int LDS_BYTES = 147456;
constexpr int RED_OFF = 131072;

__device__ __forceinline__ unsigned pk2(float lo, float hi) { f32x2 v = {lo, hi}; bf16x2_t b = __builtin_convertvector(v, bf16x2_t); return __builtin_bit_cast(unsigned, b); }
__device__ __forceinline__ float bf2f(unsigned short b) { return __uint_as_float(((unsigned)b) << 16); }
__device__ __forceinline__ float bflo(unsigned w) { return __uint_as_float(w << 16); }
__device__ __forceinline__ float bfhi(unsigned w) { return __uint_as_float(w & 0xffff0000u); }
__device__ __forceinline__ float sigmoidf_(float x) { return __builtin_amdgcn_rcpf(1.f + __expf(-x)); }
__device__ __forceinline__ float siluf_(float x) { return x * sigmoidf_(x); }
__device__ __forceinline__ float softplusf_(float x) { return x > 20.f ? x : log1pf(__expf(x)); }
__device__ __forceinline__ float gelu_tanh(float x) { const float u = 0.7978845608f * (x + 0.044715f * x * x * x); const float t = 1.f - 2.f * __builtin_amdgcn_rcpf(__expf(2.f * u) + 1.f); return 0.5f * x * (1.f + t); }
__device__ __forceinline__ float row_rstd16(const float* ssq, int row) {
    const f32x4* p = (const f32x4*)(ssq + (size_t)row * 16); const f32x4 a = p[0], b = p[1], c = p[2], d = p[3];
    const float s = ((a[0] + a[1]) + (a[2] + a[3])) + ((b[0] + b[1]) + (b[2] + b[3])) + ((c[0] + c[1]) + (c[2] + c[3])) + ((d[0] + d[1]) + (d[2] + d[3]));
    return rsqrtf(s * (1.f / 1024.f) + EPS);
}
__device__ __forceinline__ bf16x8 pack8(const f32x4& a, const f32x4& b) { u32x4 p; p[0] = pk2(a[0], a[1]); p[1] = pk2(a[2], a[3]); p[2] = pk2(b[0], b[1]); p[3] = pk2(b[2], b[3]); return __builtin_bit_cast(bf16x8, p); }
#define MFMA16(a, b, c) __builtin_amdgcn_mfma_f32_16x16x32_bf16((a), (b), (c), 0, 0, 0)

namespace pg8 {
constexpr int BM = 256, BK = 64, HALF = 128, HTB = HALF * BK * 2, NXCD = 8, WGM = 8;
__host__ __device__ __forceinline__ int lds_byte(int r, int c) { const int st = (r >> 4) * 2 + (c >> 5), rr = r & 15, cc = c & 31, ob = rr * 64 + cc * 2; return st * 1024 + (ob ^ (((ob >> 9) & 1) << 5)); }
__host__ __device__ __forceinline__ void stage_rc(int b, int& R, int& C) { const int st = b / 1024, sb = b % 1024, swz = sb ^ (((sb >> 9) & 1) << 5); R = (st >> 1) * 16 + swz / 64; C = (st & 1) * 32 + (swz % 64) / 2; }
__host__ __device__ __forceinline__ int perm32(int rho) { const int n = rho >> 4, i = rho & 15; return 8 * (i >> 2) + 4 * n + (i & 3); }

struct Unit { int pm, pn; const char* a; const char* b; int aux; };

struct TileSched {
    int nM, nN, nwg, G, c; const char* A; const char* B; size_t tA, tB;
    __device__ void init(int M, int N, int G_, int c_, const void* A_, int lda, const void* B_, int ldb) { nM = M / BM; nN = N / BM; nwg = nM * nN; G = G_; c = c_; A = (const char*)A_; B = (const char*)B_; tA = (size_t)BM * lda * 2; tB = (size_t)BM * ldb * 2; }
    __device__ bool next(int i, Unit& u) const {
        const long L = (long)i * G + c; if (L >= nwg) return false;
        int wgid = (int)L; { const int q = nwg / NXCD, r = nwg % NXCD, xcd = wgid % NXCD, off = wgid / NXCD; wgid = (xcd < r ? xcd * (q + 1) : r * (q + 1) + (xcd - r) * q) + off; }
        const int nig = WGM * nN, gid = wgid / nig, fm = gid * WGM, gsz = (nM - fm) < WGM ? (nM - fm) : WGM;
        u.pm = fm + ((wgid % nig) % gsz); u.pn = (wgid % nig) / gsz; u.a = A + (size_t)u.pm * tA; u.b = B + (size_t)u.pn * tB; u.aux = 0; return true;
    }
};

template <class Epi, class Sched>
__device__ __forceinline__ void gemm_phase(LAS unsigned char* lds, const int lda, const int ldb, const int K, const Sched& S, const Epi& E) {
    int tid_ = threadIdx.x; asm volatile("" : "+v"(tid_));
    const int tid = tid_, wid = __builtin_amdgcn_readfirstlane(tid >> 6), lane = tid & 63, wr = wid >> 2, wc = wid & 3, fr = lane & 15, fq = lane >> 4;
    int Kv_ = K; asm volatile("" : "+s"(Kv_));
    const int nt = Kv_ / BK;
    unsigned voffA[2], voffB[2];
#pragma unroll
    for (int i = 0; i < 2; ++i) { int R, C; stage_rc(tid * 16 + i * 8192, R, C); const int Rb = Epi::PERM ? ((R & ~31) + perm32(R & 31)) : R;
        voffA[i] = (unsigned)(R * lda + C) * 2u; voffB[i] = (unsigned)(Rb * ldb + C) * 2u; }
    const size_t kstep = (size_t)(BK * 2);
    const size_t hstepA = (size_t)HALF * lda * 2, hstepB = (size_t)HALF * ldb * 2;
    const unsigned ldsw = (unsigned)wid * 1024u;
    const int aoff = lds_byte(wr * 64 + fr, fq * 8), boff = lds_byte(wc * 32 + fr, fq * 8);
#define PG8_SA(b, h) (((b) * 2 + (h)) * HTB)
#define PG8_SB(b, h) ((4 + (b) * 2 + (h)) * HTB)
#define PG8_STAGE(bufoff, gbase, voff) do { _Pragma("unroll") for (int _i = 0; _i < 2; ++_i) \
        __builtin_amdgcn_global_load_lds((const unsigned*)((const char*)(gbase) + (voff)[_i]), (LAS unsigned*)(lds + (bufoff) + ldsw + _i * 8192), 16, 0, 0); } while (0)
#define PG8_LDA(dst, b, h) do { _Pragma("unroll") for (int m = 0; m < 4; ++m) _Pragma("unroll") for (int k = 0; k < 2; ++k) dst[m][k] = *(const LAS bf16x8*)(lds + PG8_SA(b, h) + aoff + m * 2048 + k * 1024); } while (0)
#define PG8_LDB(dst, b, h) do { _Pragma("unroll") for (int n = 0; n < 2; ++n) _Pragma("unroll") for (int k = 0; k < 2; ++k) dst[n][k] = *(const LAS bf16x8*)(lds + PG8_SB(b, h) + boff + n * 2048 + k * 1024); } while (0)
#define PG8_MMA(ai, bj, At, Bt) do { __builtin_amdgcn_s_setprio(1); _Pragma("unroll") for (int m = 0; m < 4; ++m) _Pragma("unroll") for (int n = 0; n < 2; ++n) _Pragma("unroll") for (int k = 0; k < 2; ++k) \
        acc[ai][bj][m][n] = __builtin_amdgcn_mfma_f32_16x16x32_bf16(Bt[n][k], At[m][k], acc[ai][bj][m][n], 0, 0, 0); __builtin_amdgcn_s_setprio(0); } while (0)
#define PG8_WAIT_V(n) asm volatile("s_waitcnt vmcnt(" #n ")" ::: "memory")
#define PG8_WAIT_L(n) asm volatile("s_waitcnt lgkmcnt(" #n ")" ::: "memory")
#define PG8_BAR __builtin_amdgcn_s_barrier()
#define PG8_SCHED __builtin_amdgcn_sched_barrier(0)
    Unit cur, nxt; int ui = 0;
    if (!S.next(0, cur)) return;
    f32x4 acc[2][2][4][2];
#pragma unroll
    for (int a = 0; a < 2; ++a)
#pragma unroll
        for (int b = 0; b < 2; ++b)
#pragma unroll
            for (int m = 0; m < 4; ++m)
#pragma unroll
                for (int n = 0; n < 2; ++n) acc[a][b][m][n] = (f32x4){0.f, 0.f, 0.f, 0.f};
    bf16x8 At[4][2], B0[2][2], B1[2][2];
    const char* cA = cur.a; const char* cB = cur.b;
    PG8_STAGE(PG8_SB(0, 0), cB, voffB); PG8_STAGE(PG8_SB(0, 1), cB + hstepB, voffB); PG8_STAGE(PG8_SA(0, 0), cA, voffA); PG8_STAGE(PG8_SA(0, 1), cA + hstepA, voffA);
    if (wr == 1) PG8_BAR;
    PG8_WAIT_V(2); PG8_BAR;
    PG8_STAGE(PG8_SB(1, 0), cB + kstep, voffB); PG8_STAGE(PG8_SA(1, 0), cA + kstep, voffA); PG8_STAGE(PG8_SB(1, 1), cB + hstepB + kstep, voffB);
    PG8_WAIT_V(6); PG8_BAR;
    for (;;) {
        const bool has_next = S.next(ui + 1, nxt);
        const char* nA = has_next ? nxt.a : cA; const char* nB = has_next ? nxt.b : cB;
        for (int t = 0; t < nt; t += 2) {
            const bool last = (t == nt - 2);
            const char* a1 = cA + (size_t)(t + 1) * kstep;
            const char* a2 = last ? nA : cA + (size_t)(t + 2) * kstep; const char* b2 = last ? nB : cB + (size_t)(t + 2) * kstep;
            const char* a3 = a2 + kstep; const char* b3 = b2 + kstep;
            PG8_LDB(B0, 0, 0); PG8_LDB(B1, 0, 1); PG8_SCHED; PG8_LDA(At, 0, 0); PG8_STAGE(PG8_SA(1, 1), a1 + hstepA, voffA);
            PG8_WAIT_V(8); PG8_WAIT_L(0); PG8_BAR; PG8_MMA(0, 0, At, B0); PG8_MMA(0, 1, At, B1); PG8_BAR; PG8_SCHED;
            PG8_LDA(At, 0, 1); PG8_STAGE(PG8_SB(0, 0), b2, voffB); PG8_STAGE(PG8_SB(0, 1), b2 + hstepB, voffB); PG8_STAGE(PG8_SA(0, 0), a2, voffA);
            PG8_WAIT_V(8); PG8_WAIT_L(0); PG8_BAR; PG8_MMA(1, 0, At, B0); PG8_MMA(1, 1, At, B1); PG8_BAR; PG8_SCHED;
            PG8_LDB(B0, 1, 0); PG8_LDB(B1, 1, 1); PG8_SCHED; PG8_LDA(At, 1, 0); PG8_STAGE(PG8_SA(0, 1), a2 + hstepA, voffA);
            PG8_WAIT_V(8); PG8_WAIT_L(0); PG8_BAR; PG8_MMA(0, 0, At, B0); PG8_MMA(0, 1, At, B1); PG8_BAR; PG8_SCHED;
            PG8_LDA(At, 1, 1); PG8_STAGE(PG8_SB(1, 0), b3, voffB); PG8_STAGE(PG8_SB(1, 1), b3 + hstepB, voffB); PG8_STAGE(PG8_SA(1, 0), a3, voffA);
            PG8_WAIT_V(8); PG8_WAIT_L(0); PG8_BAR; PG8_MMA(1, 0, At, B0); PG8_MMA(1, 1, At, B1); PG8_BAR; PG8_SCHED;
        }
        if (wr == 0) PG8_BAR;
        E(acc, cur, wr, wc, fr, fq);
        if (!has_next) break;
#pragma unroll
        for (int a = 0; a < 2; ++a)
#pragma unroll
            for (int b = 0; b < 2; ++b)
#pragma unroll
                for (int m = 0; m < 4; ++m)
#pragma unroll
                    for (int n = 0; n < 2; ++n) acc[a][b][m][n] = (f32x4){0.f, 0.f, 0.f, 0.f};
        cur = nxt; cA = nA; cB = nB; ++ui;
        if (wr == 1) PG8_BAR;
    }
    PG8_WAIT_V(0);
    PG8_BAR;
#undef PG8_SA
#undef PG8_SB
#undef PG8_STAGE
#undef PG8_LDA
#undef PG8_LDB
#undef PG8_MMA
#undef PG8_WAIT_V
#undef PG8_WAIT_L
#undef PG8_SCHED
}


__device__ __forceinline__ void rs_fill(const float* ssq, int pm, LAS float* rsl, int tid) {
    asm volatile("s_waitcnt lgkmcnt(0)" ::: "memory"); __builtin_amdgcn_s_barrier(); asm volatile("" ::: "memory");
    if (tid < 256) rsl[tid] = row_rstd16(ssq, pm * 256 + tid);
    asm volatile("s_waitcnt lgkmcnt(0)" ::: "memory"); __builtin_amdgcn_s_barrier(); asm volatile("" ::: "memory");
}
#define EPI_FENCE() asm volatile("" ::: "memory")
typedef f32x4 Acc[2][2][4][2];

struct EpiSwiGLU {
    static constexpr bool PERM = true;
    bf16* H; const float* ssq; LAS float* rsl;
    __device__ __forceinline__ void operator()(Acc& acc, const Unit& u, int wr, int wc, int fr, int fq) const {
        asm volatile("" : "+v"(fr), "+v"(fq));
        const int row0 = u.pm * BM + wr * 64 + fr, col0 = u.pn * 128 + wc * 32 + 8 * fq;
        rs_fill(ssq, u.pm, rsl, (wr * 4 + wc) * 64 + fq * 16 + fr);
#pragma unroll
        for (int ai = 0; ai < 2; ++ai)
#pragma unroll
            for (int m = 0; m < 4; ++m) { const int row = row0 + ai * HALF + m * 16; const float rs = rsl[row & 255]; EPI_FENCE();
                float h[8];
#pragma unroll
                for (int n = 0; n < 2; ++n)
#pragma unroll
                    for (int j = 0; j < 4; ++j) { const float g = acc[ai][0][m][n][j] * rs, up = acc[ai][1][m][n][j] * rs; h[n * 4 + j] = siluf_(g) * up; }
                u32x4 w; w.x = pk2(h[0], h[1]); w.y = pk2(h[2], h[3]); w.z = pk2(h[4], h[5]); w.w = pk2(h[6], h[7]);
                *(u32x4*)(H + (size_t)row * FF + col0) = w; }
    }
};
struct EpiResid {
    static constexpr bool PERM = false;
    float* X; bf16* XB; float* ssq; float alpha;
    __device__ __forceinline__ void operator()(Acc& acc, const Unit& u, int wr, int wc, int fr, int fq) const {
        asm volatile("" : "+v"(fr), "+v"(fq));
        const int row0 = u.pm * BM + wr * 64 + fr, col0 = u.pn * BM + wc * 32 + 4 * fq;
#pragma unroll
        for (int ai = 0; ai < 2; ++ai)
#pragma unroll
            for (int m = 0; m < 4; ++m) { const int row = row0 + ai * HALF + m * 16; float sq = 0.f;
#pragma unroll
                for (int bj = 0; bj < 2; ++bj)
#pragma unroll
                    for (int n = 0; n < 2; ++n) { const size_t off = (size_t)row * D + col0 + bj * HALF + n * 16;
                        f32x4 xv = *(const f32x4*)(X + off); xv = xv + acc[ai][bj][m][n] * alpha; *(f32x4*)(X + off) = xv;
                        u32x2 w; w.x = pk2(xv[0], xv[1]); w.y = pk2(xv[2], xv[3]); *(u32x2*)(XB + off) = w;
                        sq += (xv[0] * xv[0] + xv[1] * xv[1]) + (xv[2] * xv[2] + xv[3] * xv[3]); }
                sq += __shfl_xor(sq, 16); sq += __shfl_xor(sq, 32);
                if (fq == 0) ssq[(size_t)row * 16 + u.pn * 4 + wc] = sq; EPI_FENCE(); }
    }
};
struct EpiBf16 {
    static constexpr bool PERM = true;
    bf16* O; int ldc; const float* rsp; int mode; float scale; LAS float* rsl;
    __device__ __forceinline__ void store(Acc& acc, bf16* base, int row0, int col0) const {
#pragma unroll
        for (int ai = 0; ai < 2; ++ai)
#pragma unroll
            for (int m = 0; m < 4; ++m) { const int row = row0 + ai * HALF + m * 16;
                float rs = scale; if (mode == 1) rs *= rsl[row & 255]; else if (mode == 2) rs *= rsp[row]; EPI_FENCE();
                bf16* rowp = base + (size_t)row * ldc + col0;
#pragma unroll
                for (int bj = 0; bj < 2; ++bj) { const f32x4 v0 = acc[ai][bj][m][0] * rs, v1 = acc[ai][bj][m][1] * rs;
                    u32x4 w; w.x = pk2(v0[0], v0[1]); w.y = pk2(v0[2], v0[3]); w.z = pk2(v1[0], v1[1]); w.w = pk2(v1[2], v1[3]);
                    *(u32x4*)(rowp + bj * HALF) = w; } }
    }
    __device__ __forceinline__ void operator()(Acc& acc, const Unit& u, int wr, int wc, int fr, int fq) const {
        asm volatile("" : "+v"(fr), "+v"(fq));
        if (mode == 1) rs_fill(rsp, u.pm, rsl, (wr * 4 + wc) * 64 + fq * 16 + fr);
        store(acc, O, u.pm * BM + wr * 64 + fr, u.pn * BM + wc * 32 + 8 * fq);
    }
};
template <int kind> struct EpiPrep {
    static constexpr bool PERM = true;
    unsigned char* ws;
    __device__ __forceinline__ void operator()(Acc& acc, const Unit& u, int wr, int wc, int fr, int fq) const {
        asm volatile("" : "+v"(fr), "+v"(fq));
        EpiBf16 e; e.rsl = nullptr; const int r0 = wr * 64 + fr, c0 = wc * 32 + 8 * fq;
        if constexpr (kind == 0) { const int l = u.aux >> 3, t = u.aux & 7; e.O = (bf16*)(ws + WS_KV) + (size_t)l * 256 * 2048; e.ldc = 2048; e.rsp = (const float*)(ws + WS_MEMRS); e.mode = 2; e.scale = 1.f; e.store(acc, e.O, r0, t * 256 + c0); }
        else if constexpr (kind == 1) { const int l = u.aux >> 4, h = (u.aux >> 2) & 3, t = u.aux & 3; e.O = (bf16*)(ws + WS_WQK) + (size_t)l * 1024 * 1024; e.ldc = 1024; e.rsp = nullptr; e.mode = 0; e.scale = 1.f; e.store(acc, e.O, h * 256 + r0, t * 256 + c0); }
        else { const int l = u.aux >> 4, h = (u.aux >> 2) & 3, t = u.aux & 3; e.O = (bf16*)(ws + WS_WVO) + (size_t)l * 1024 * 1024; e.ldc = 1024; e.rsp = nullptr; e.mode = 0; e.scale = 1.f; e.store(acc, e.O, t * 256 + r0, h * 256 + c0); }
    }
};
struct EpiDN {
    static constexpr bool PERM = true;
    bf16* QKV; bf16* Z; bf16* HALO; float* AB; const float* ssq; const float* a_log; const float* dt_bias; LAS float* rsl;
    __device__ __forceinline__ void operator()(Acc& acc, const Unit& u, int wr, int wc, int fr, int fq) const {
        asm volatile("" : "+v"(fr), "+v"(fq));
        const int row0 = u.pm * BM + wr * 64 + fr, c0 = wc * 32 + 8 * fq;
        rs_fill(ssq, u.pm, rsl, (wr * 4 + wc) * 64 + fq * 16 + fr);
#pragma unroll
        for (int ai = 0; ai < 2; ++ai)
#pragma unroll
            for (int m = 0; m < 4; ++m) { const int row = row0 + ai * HALF + m * 16; const float rs = rsl[row & 255]; EPI_FENCE();
                if (u.pn < 16) {
#pragma unroll
                    for (int bj = 0; bj < 2; ++bj) { const f32x4 v0 = acc[ai][bj][m][0] * rs, v1 = acc[ai][bj][m][1] * rs;
                        u32x4 w; w.x = pk2(v0[0], v0[1]); w.y = pk2(v0[2], v0[3]); w.z = pk2(v1[0], v1[1]); w.w = pk2(v1[2], v1[3]);
                        if (u.pn < 12) { const int col = u.pn * 256 + bj * HALF + c0; *(u32x4*)(QKV + (size_t)row * QKVW + col) = w;
                            if ((row & 63) >= 61) *(u32x4*)(HALO + ((size_t)(row >> 6) * 3 + ((row & 63) - 61)) * QKVW + col) = w; }
                        else { const int col = (u.pn - 12) * 256 + bj * HALF + c0; *(u32x4*)(Z + (size_t)row * D + col) = w; } }
                } else if (wc == 0 && fq < 2) {
#pragma unroll
                    for (int n = 0; n < 2; ++n) { f32x4 o;
#pragma unroll
                        for (int j = 0; j < 4; ++j) { const float v = acc[ai][0][m][n][j] * rs; const int h = 4 * n + j;
                            o[j] = (fq == 0) ? -__expf(a_log[h]) * softplusf_(v + dt_bias[h]) : sigmoidf_(v); }
                        *(f32x4*)(AB + (size_t)row * 16 + 8 * fq + 4 * n) = o; }
                } }
    }
};
struct EpiSoftmax {
    static constexpr bool PERM = true;
    bf16* P; const float* ssq; LAS float* red;
    __device__ __forceinline__ void operator()(Acc& acc, const Unit& u, int wr, int wc, int fr, int fq) const {
        asm volatile("" : "+v"(fr), "+v"(fq));
        const int rl0 = wr * 64 + fr, col0 = u.pn * BM + wc * 32 + 8 * fq;
        float mx[2][4];
        rs_fill(ssq, u.pm, red + 2048, (wr * 4 + wc) * 64 + fq * 16 + fr);
#pragma unroll
        for (int ai = 0; ai < 2; ++ai)
#pragma unroll
            for (int m = 0; m < 4; ++m) { const int rl = rl0 + ai * HALF + m * 16; const float rs = red[2048 + rl]; float t = -3.0e38f;
#pragma unroll
                for (int bj = 0; bj < 2; ++bj)
#pragma unroll
                    for (int n = 0; n < 2; ++n) { acc[ai][bj][m][n] = acc[ai][bj][m][n] * rs; const f32x4 v = acc[ai][bj][m][n]; t = fmaxf(t, fmaxf(fmaxf(v[0], v[1]), fmaxf(v[2], v[3]))); }
                t = fmaxf(t, __shfl_xor(t, 16)); t = fmaxf(t, __shfl_xor(t, 32));
                if (fq == 0) red[rl * 4 + wc] = t; }
        __syncthreads();
#pragma unroll
        for (int ai = 0; ai < 2; ++ai)
#pragma unroll
            for (int m = 0; m < 4; ++m) { const int rl = rl0 + ai * HALF + m * 16; const f32x4 r = *(const LAS f32x4*)(red + rl * 4);
                const float M = fmaxf(fmaxf(r[0], r[1]), fmaxf(r[2], r[3])); float s = 0.f;
#pragma unroll
                for (int bj = 0; bj < 2; ++bj)
#pragma unroll
                    for (int n = 0; n < 2; ++n) { f32x4 v = acc[ai][bj][m][n];
#pragma unroll
                        for (int j = 0; j < 4; ++j) { v[j] = __expf(v[j] - M); s += v[j]; }
                        acc[ai][bj][m][n] = v; }
                s += __shfl_xor(s, 16); s += __shfl_xor(s, 32);
                if (fq == 0) red[1024 + rl * 4 + wc] = s; mx[ai][m] = 0.f; }
        __syncthreads();
#pragma unroll
        for (int ai = 0; ai < 2; ++ai)
#pragma unroll
            for (int m = 0; m < 4; ++m) { const int rl = rl0 + ai * HALF + m * 16; const f32x4 r = *(const LAS f32x4*)(red + 1024 + rl * 4);
                const float inv = 1.f / ((r[0] + r[1]) + (r[2] + r[3]));
                bf16* rowp = P + (size_t)(u.pm * BM + rl) * D + col0;
#pragma unroll
                for (int bj = 0; bj < 2; ++bj) { const f32x4 v0 = acc[ai][bj][m][0] * inv, v1 = acc[ai][bj][m][1] * inv;
                    u32x4 w; w.x = pk2(v0[0], v0[1]); w.y = pk2(v0[2], v0[3]); w.z = pk2(v1[0], v1[1]); w.w = pk2(v1[2], v1[3]);
                    *(u32x4*)(rowp + bj * HALF) = w; } }
        __syncthreads();
        (void)mx;
    }
};
struct KvSched {
    int G, c; const unsigned char* ws;
    __device__ bool next(int i, Unit& u) const { const int L = i * G + c; if (L >= 16) return false; const int l = L >> 3, t = L & 7; u.pm = 0; u.pn = t; u.aux = L;
        u.a = (const char*)(ws + WS_MEMB); u.b = (const char*)(ws + WS_BIG + (size_t)l * 8 * MiB) + (size_t)t * 256 * 1024 * 2; return true; }
};
struct QkSched {
    int G, c; const unsigned char* ws;
    __device__ bool next(int i, Unit& u) const { const int L = i * G + c; if (L >= 32) return false; const int l = L >> 4, h = (L >> 2) & 3, t = L & 3; u.pm = 0; u.pn = 0; u.aux = L;
        u.a = (const char*)(ws + WS_KV) + ((size_t)l * 256 * 2048 + h * 256) * 2;
        u.b = (const char*)(ws + WS_BIG + (size_t)l * 8 * MiB + 4 * MiB) + ((size_t)t * 256 * 1024 + h * 256) * 2; return true; }
};
struct VoSched {
    int G, c; const unsigned char* ws;
    __device__ bool next(int i, Unit& u) const { const int L = i * G + c; if (L >= 32) return false; const int l = L >> 4, h = (L >> 2) & 3, t = L & 3; u.pm = 0; u.pn = 0; u.aux = L;
        u.a = (const char*)(ws + WS_BIG + (size_t)l * 8 * MiB + 6 * MiB) + ((size_t)t * 256 * 1024 + h * 256) * 2;
        u.b = (const char*)(ws + WS_KV) + ((size_t)l * 256 * 2048 + 1024 + h * 256) * 2; return true; }
};
#undef PG8_BAR
}

__device__ __forceinline__ void transpose_item(const float* W, int K, int N, bf16* WT, const float* gk, int mode, LAS float* scr, int item, int lane) {
    const int nblk = (N + 31) / 32, kb = item / nblk, nb = item % nblk, k0 = 64 * kb, n0 = 32 * nb;
    const int nn = n0 + (lane & 31);
#pragma unroll 8
    for (int i = 0; i < 32; ++i) { const int kk = 2 * i + (lane >> 5); float v = nn < N ? W[(size_t)(k0 + kk) * N + nn] : 0.f; if (gk) v *= gk[k0 + kk]; scr[kk * 33 + (lane & 31)] = v; }
    asm volatile("s_waitcnt lgkmcnt(0)" ::: "memory");
    const int c = lane & 7;
#pragma unroll
    for (int j = 0; j < 4; ++j) { const int n = (lane >> 3) + 8 * j; const LAS float* s = scr + (8 * c) * 33 + n;
        u32x4 o; o.x = pk2(s[0 * 33], s[1 * 33]); o.y = pk2(s[2 * 33], s[3 * 33]); o.z = pk2(s[4 * 33], s[5 * 33]); o.w = pk2(s[6 * 33], s[7 * 33]);
        int nr = n0 + n;
        if (mode == 1) { nr = nr < FF ? ((nr >> 7) * 256 + (nr & 127)) : (((nr - FF) >> 7) * 256 + 128 + ((nr - FF) & 127)); }
        *(u32x4*)(WT + (size_t)nr * K + k0 + 8 * c) = o; }
    asm volatile("s_waitcnt lgkmcnt(0)" ::: "memory");
}
__device__ __forceinline__ float wave_sum(float v) {
#pragma unroll
    for (int o = 1; o < 64; o <<= 1) v += __shfl_xor(v, o);
    return v;
}

struct Args { const float* in[30]; float* out; unsigned char* ws; };
__device__ __forceinline__ const void* karg(int i) {
    const __attribute__((address_space(4))) char* k = (const __attribute__((address_space(4))) char*)__builtin_amdgcn_kernarg_segment_ptr();
    asm volatile("" : "+s"(k));
    return *(const void* const __attribute__((address_space(4)))*)(k + 8 * i);
}
#define argin(i) ((const float*)karg(i))
#define argout() ((float*)karg(30))
#define argws() ((unsigned char*)karg(31))


#define TJ_RUN(W_, K_, N_, WT_, gk_, mode_) do { const int n_ = ((K_) / 64) * (((N_) + 31) / 32); for (int it = gw; it < n_; it += NGW) transpose_item((W_), (K_), (N_), (WT_), (gk_), (mode_), scr, it, lane); } while (0)
__device__ __forceinline__ void layer_weights(int l, int gw, int NGW, LAS float* scr, int lane) {
    unsigned char* ws = argws();
    TJ_RUN(argin(3) + (size_t)l * D * 2 * FF, D, 2 * FF, (bf16*)(ws + WS_F1IN), argin(2) + l * D, 1);
    TJ_RUN(argin(4) + (size_t)l * FF * D, FF, D, (bf16*)(ws + WS_F1OUT), (const float*)nullptr, 0);
    TJ_RUN(argin(12) + (size_t)l * D * 2 * FF, D, 2 * FF, (bf16*)(ws + WS_F2IN), argin(11) + l * D, 1);
    TJ_RUN(argin(13) + (size_t)l * FF * D, FF, D, (bf16*)(ws + WS_F2OUT), (const float*)nullptr, 0);
    if (l == 0) { TJ_RUN(argin(14), D, ABN, (bf16*)(ws + WS_MIXIN), argin(5), 0); TJ_RUN(argin(22), D, D, (bf16*)(ws + WS_MIXOUT), (const float*)nullptr, 0); }
    else { TJ_RUN(argin(23), D, DNREAL, (bf16*)(ws + WS_MIXIN), argin(5) + D, 0); TJ_RUN(argin(28), D, D, (bf16*)(ws + WS_MIXOUT), (const float*)nullptr, 0);
        u32x4* p = (u32x4*)((bf16*)(ws + WS_MIXIN) + (size_t)4128 * D); const int n16 = (DNN - 4128) * D * 2 / 16;
        unsigned zz = 0u; asm volatile("" : "+v"(zz));
        for (int i = gw * 64 + lane; i < n16; i += NGW * 64) p[i] = (u32x4){zz, zz, zz, zz};
    }
}

__device__ __forceinline__ void attn_unit(const bf16* __restrict__ QKV, bf16* __restrict__ OB, LAS unsigned char* vt, int u, int lane) {
    const int r16 = u & 15, h = (u >> 4) & 7, blk = u >> 7;
    const int t0 = blk * 256 + r16;
    const int c = lane & 15, q = lane >> 4;
    const bf16* qrow = QKV + (size_t)(t0 + 16 * c) * ABN + h * 64;
    const bf16x8 qf0 = *(const bf16x8*)(qrow + 8 * q), qf1 = *(const bf16x8*)(qrow + 32 + 8 * q);
    float mrun = -1.0e30f, lrun = 0.f;
    f32x4 o[4];
#pragma unroll
    for (int i = 0; i < 4; ++i) o[i] = (f32x4){0.f, 0.f, 0.f, 0.f};
    const float SC = 0.125f * 1.4426950408889634f;
    const int kk = lane & 31, hf = lane >> 5;
    for (int di = 0; di < 3; ++di) {
        const int d = 1 << (2 * di), e = 16 >> (2 * di);
        const int kstart = t0 - 128 * d;
        const int ntile = (128 + 15 * e + 1 + 31) >> 5;
        const int lo = c * e, hi = c * e + 128;
        for (int T = 0; T < ntile; ++T) {
            f32x4 s0 = (f32x4){0.f, 0.f, 0.f, 0.f}, s1 = s0;
            { int tok = kstart + (32 * T + c) * d; tok = tok < 0 ? 0 : (tok > S - 1 ? S - 1 : tok);
              const bf16* krow = QKV + (size_t)tok * ABN + 512 + h * 64;
              const bf16x8 k0 = *(const bf16x8*)(krow + 8 * q), k1 = *(const bf16x8*)(krow + 32 + 8 * q);
              s0 = MFMA16(k0, qf0, s0); s0 = MFMA16(k1, qf1, s0); }
            { int tok = kstart + (32 * T + 16 + c) * d; tok = tok < 0 ? 0 : (tok > S - 1 ? S - 1 : tok);
              const bf16* krow = QKV + (size_t)tok * ABN + 512 + h * 64;
              const bf16x8 k0 = *(const bf16x8*)(krow + 8 * q), k1 = *(const bf16x8*)(krow + 32 + 8 * q);
              s1 = MFMA16(k0, qf0, s1); s1 = MFMA16(k1, qf1, s1); }
            u32x4 vv[4];
            { int tok = kstart + (32 * T + kk) * d; tok = tok < 0 ? 0 : (tok > S - 1 ? S - 1 : tok);
              const u32x4* vrow = (const u32x4*)(QKV + (size_t)tok * ABN + 1024 + h * 64 + hf * 32);
#pragma unroll
              for (int i = 0; i < 4; ++i) vv[i] = vrow[i]; }
            bool v0[4], v1[4]; float tmax = -1.0e30f;
#pragma unroll
            for (int i = 0; i < 4; ++i) { const int n0 = 32 * T + 4 * q + i, n1 = n0 + 16;
                v0[i] = (n0 >= lo) && (n0 <= hi) && (kstart + n0 * d >= 0); v1[i] = (n1 >= lo) && (n1 <= hi) && (kstart + n1 * d >= 0);
                s0[i] = v0[i] ? s0[i] * SC : -1.0e30f; s1[i] = v1[i] ? s1[i] * SC : -1.0e30f;
                tmax = fmaxf(tmax, fmaxf(s0[i], s1[i])); }
            tmax = fmaxf(tmax, __shfl_xor(tmax, 16)); tmax = fmaxf(tmax, __shfl_xor(tmax, 32));
            const float mnew = fmaxf(mrun, tmax), alpha = exp2f(mrun - mnew);
            float ps = 0.f; f32x4 p0, p1;
#pragma unroll
            for (int i = 0; i < 4; ++i) { p0[i] = v0[i] ? exp2f(s0[i] - mnew) : 0.f; p1[i] = v1[i] ? exp2f(s1[i] - mnew) : 0.f; ps += p0[i] + p1[i]; }
            ps += __shfl_xor(ps, 16); ps += __shfl_xor(ps, 32);
            lrun = lrun * alpha + ps; mrun = mnew;
#pragma unroll
            for (int i = 0; i < 4; ++i) o[i] = o[i] * alpha;
            const bf16x8 pb = pack8(p0, p1);
#pragma unroll
            for (int i = 0; i < 4; ++i)
#pragma unroll
                for (int j = 0; j < 4; ++j) { const unsigned w = vv[i][j]; const int dim = hf * 32 + i * 8 + j * 2;
                    *(LAS unsigned short*)(vt + dim * 80 + kk * 2) = (unsigned short)(w & 0xffffu);
                    *(LAS unsigned short*)(vt + (dim + 1) * 80 + kk * 2) = (unsigned short)(w >> 16); }
            __builtin_amdgcn_wave_barrier(); asm volatile("s_waitcnt lgkmcnt(0)" ::: "memory");
#pragma unroll
            for (int Dt = 0; Dt < 4; ++Dt) { const LAS unsigned char* rp = vt + (16 * Dt + c) * 80 + 8 * q;
                const s16x4 lo8 = *(const LAS s16x4*)rp, hi8 = *(const LAS s16x4*)(rp + 32);
                const bf16x8 vf = __builtin_shufflevector(lo8, hi8, 0, 1, 2, 3, 4, 5, 6, 7);
                o[Dt] = MFMA16(vf, pb, o[Dt]); }
            __builtin_amdgcn_wave_barrier(); asm volatile("s_waitcnt lgkmcnt(0)" ::: "memory");
        }
    }
    const float inv = 1.f / lrun;
    bf16* orow = OB + (size_t)(t0 + 16 * c) * D + h * 64 + 4 * q;
#pragma unroll
    for (int Dt = 0; Dt < 4; ++Dt) { u32x2 w; w.x = pk2(o[Dt][0] * inv, o[Dt][1] * inv); w.y = pk2(o[Dt][2] * inv, o[Dt][3] * inv); *(u32x2*)(orow + 16 * Dt) = w; }
}

__device__ __forceinline__ void lru_local_unit(LAS float* L, int unit) {
    int tid_l = threadIdx.x; asm volatile("" : "+v"(tid_l));
    const int tt = unit >> 3, cb = unit & 7, tid = tid_l, k = tid & 63, tg = tid >> 6;
    const bf16* XG = (const bf16*)(argws() + WS_BIG);
    LAS float* xc = L; LAS float* wa = L + 64 * 65; LAS float* wx = wa + 4096; LAS float* LA = wx + 4096; LAS float* LB = LA + 64 * 65;
    const float* Wa = argin(17) + (size_t)cb * 4096; const float* Wx = argin(19) + (size_t)cb * 4096;
    for (int i = tid; i < 4096; i += 512) { wa[i] = Wa[i]; wx[i] = Wx[i]; }
    const int ch = cb * 64 + k;
    { const float cw0 = argin(15)[ch], cw1 = argin(15)[512 + ch], cw2 = argin(15)[1024 + ch], cw3 = argin(15)[1536 + ch], cbias = argin(16)[ch];
      const int tb = tt * 64 + tg * 8;
      float xm3 = tb - 3 >= 0 ? bf2f(XG[(size_t)(tb - 3) * ABN + 1536 + ch]) : 0.f, xm2 = tb - 2 >= 0 ? bf2f(XG[(size_t)(tb - 2) * ABN + 1536 + ch]) : 0.f, xm1 = tb - 1 >= 0 ? bf2f(XG[(size_t)(tb - 1) * ABN + 1536 + ch]) : 0.f;
#pragma unroll
      for (int i = 0; i < 8; ++i) { const float x0 = bf2f(XG[(size_t)(tb + i) * ABN + 1536 + ch]);
          xc[(tg * 8 + i) * 65 + k] = cbias + cw0 * xm3 + cw1 * xm2 + cw2 * xm1 + cw3 * x0; xm3 = xm2; xm2 = xm1; xm1 = x0; } }
    __syncthreads();
    float ra[8], ri[8];
#pragma unroll
    for (int i = 0; i < 8; ++i) { ra[i] = 0.f; ri[i] = 0.f; }
    for (int j = 0; j < 64; ++j) { const float aw = wa[j * 64 + k], xw = wx[j * 64 + k];
#pragma unroll
        for (int i = 0; i < 8; ++i) { const float xv = xc[(tg * 8 + i) * 65 + j]; ra[i] += xv * aw; ri[i] += xv * xw; } }
    { const float ba = argin(18)[ch], bx = argin(20)[ch], spl = softplusf_(-argin(21)[ch]);
#pragma unroll
      for (int i = 0; i < 8; ++i) { const float r = sigmoidf_(ra[i] + ba), ig = sigmoidf_(ri[i] + bx);
          const float log_a = -8.0f * r * spl; const float av = __expf(log_a); const float mult = sqrtf(-expm1f(2.f * log_a));
          LA[(tg * 8 + i) * 65 + k] = av; LB[(tg * 8 + i) * 65 + k] = mult * ig * xc[(tg * 8 + i) * 65 + k]; } }
    __syncthreads();
    if (tid < 64) { float hh = 0.f, pp = 1.f;
        for (int t = 0; t < 64; ++t) { const float av = LA[t * 65 + tid], bv = LB[t * 65 + tid]; hh = av * hh + bv; pp *= av; LB[t * 65 + tid] = hh; LA[t * 65 + tid] = pp; }
        float* TOT = (float*)(argws() + WS_LRUTOT); TOT[(size_t)tt * 512 + cb * 64 + tid] = pp; TOT[(size_t)(256 + tt) * 512 + cb * 64 + tid] = hh; }
    __syncthreads();
    { float* HL = (float*)(argws() + WS_XB); float* PC = (float*)(argws() + WS_BIG + 80 * MiB);
#pragma unroll
      for (int i = 0; i < 8; ++i) { const size_t off = (size_t)(tt * 64 + tg * 8 + i) * 512 + ch; HL[off] = LB[(tg * 8 + i) * 65 + k]; PC[off] = LA[(tg * 8 + i) * 65 + k]; } }
    __syncthreads();
}
__device__ __forceinline__ void lru_apply_unit(LAS float* L, int unit) {
    int tid_l = threadIdx.x; asm volatile("" : "+v"(tid_l));
    const int tt = unit >> 3, cb = unit & 7, tid = tid_l, k = tid & 63, tg = tid >> 6, ch = cb * 64 + k;
    if (tid < 64) { const float* TOT = (const float*)(argws() + WS_LRUTOT); float H = 0.f;
        for (int c = 0; c < tt; ++c) H = TOT[(size_t)c * 512 + ch] * H + TOT[(size_t)(256 + c) * 512 + ch];
        L[tid] = H; }
    __syncthreads();
    const float Hin = L[k];
    const float* HL = (const float*)(argws() + WS_XB); const float* PC = (const float*)(argws() + WS_BIG + 80 * MiB);
    const bf16* XG = (const bf16*)(argws() + WS_BIG); bf16* OB = (bf16*)(argws() + WS_OB);
#pragma unroll
    for (int i = 0; i < 8; ++i) { const int t = tt * 64 + tg * 8 + i; const size_t off = (size_t)t * 512 + ch;
        const float hv = HL[off] + PC[off] * Hin; const float gr = bf2f(XG[(size_t)t * ABN + 2048 + ch]);
        const float hb = bf2f((unsigned short)(pk2(hv, 0.f) & 0xffffu));
        (void)hb;
        OB[(size_t)t * D + 512 + ch] = (unsigned short)(pk2(hv * gelu_tanh(gr), 0.f) & 0xffffu); }
    __syncthreads();
}

__device__ __forceinline__ void dn_local_unit(LAS unsigned char* lds, int unit) {
    int tid_l = threadIdx.x; asm volatile("" : "+v"(tid_l));
    const int c = unit >> 3, h = unit & 7, tid = tid_l, lane = tid & 63, wid = tid >> 6;
    bf16* QKV = (bf16*)(argws() + WS_BIG); const bf16* HALO = (const bf16*)(argws() + WS_HALO);
    const float* AB = (const float*)(argws() + WS_DNAB);
    LAS unsigned char* qb = lds; LAS unsigned char* kb = lds + 17408; LAS unsigned char* vb = lds + 34816;
    LAS float* Am = (LAS float*)(lds + 52224);
    LAS float* sc = (LAS float*)(lds + 52224 + 16384);
    { const int i = tid >> 3, sg = tid & 7;
#pragma unroll
      for (int ten = 0; ten < 3; ++ten) { const int col = ten * 1024 + h * 128 + sg * 16;
          float val[16];
#pragma unroll
          for (int e = 0; e < 16; ++e) val[e] = 0.f;
#pragma unroll
          for (int j = 0; j < 4; ++j) { const int ri = i + j - 3; const bf16* src;
              bool zero = false;
              if (ri >= 0) src = QKV + (size_t)(c * 64 + ri) * QKVW + col; else if (c > 0) src = HALO + ((size_t)(c - 1) * 3 + (ri + 3)) * QKVW + col; else { zero = true; src = QKV; }
              u32x4 r0 = (u32x4){0u, 0u, 0u, 0u}, r1 = r0; if (!zero) { r0 = *(const u32x4*)src; r1 = *(const u32x4*)(src + 8); }
              const float* cw = argin(24) + (size_t)j * QKVW + col;
              const f32x4 w0 = *(const f32x4*)cw, w1 = *(const f32x4*)(cw + 4), w2 = *(const f32x4*)(cw + 8), w3 = *(const f32x4*)(cw + 12);
#pragma unroll
              for (int e = 0; e < 4; ++e) { val[2 * e] += bflo(r0[e]) * (e < 2 ? w0[2 * e] : w1[2 * e - 4]); val[2 * e + 1] += bfhi(r0[e]) * (e < 2 ? w0[2 * e + 1] : w1[2 * e - 3]);
                  val[8 + 2 * e] += bflo(r1[e]) * (e < 2 ? w2[2 * e] : w3[2 * e - 4]); val[8 + 2 * e + 1] += bfhi(r1[e]) * (e < 2 ? w2[2 * e + 1] : w3[2 * e - 3]); } }
          float ss = 0.f;
#pragma unroll
          for (int e = 0; e < 16; ++e) { val[e] = siluf_(val[e]); ss += val[e] * val[e]; }
          float scl = 1.f;
          if (ten < 2) { ss += __shfl_xor(ss, 1); ss += __shfl_xor(ss, 2); ss += __shfl_xor(ss, 4); scl = rsqrtf(ss + 1e-6f); }
          u32x4 o0, o1;
#pragma unroll
          for (int e = 0; e < 4; ++e) { o0[e] = pk2(val[2 * e] * scl, val[2 * e + 1] * scl); o1[e] = pk2(val[8 + 2 * e] * scl, val[8 + 2 * e + 1] * scl); }
          LAS unsigned char* dst = (ten == 0 ? qb : (ten == 1 ? kb : vb)) + i * 272 + sg * 32;
          *(LAS u32x4*)dst = o0; *(LAS u32x4*)(dst + 16) = o1; } }
    if (wid == 0) { const int t = c * 64 + lane; float g = AB[(size_t)t * 16 + h]; const float be = AB[(size_t)t * 16 + 8 + h];
#pragma unroll
        for (int o = 1; o < 64; o <<= 1) { const float y = __shfl_up(g, o); if (lane >= o) g += y; }
        sc[lane] = g; sc[64 + lane] = be; sc[128 + lane] = __expf(g);
        if (lane == 63) ((float*)(argws() + WS_DECAY))[c * 8 + h] = __expf(g); }
    __syncthreads();
    { const int cc = lane & 15, q = lane >> 4, rt = wid & 3; const bool isqk = wid >= 4;
      const LAS unsigned char* Ab = (isqk ? qb : kb) + (rt * 16 + cc) * 272 + 16 * q;
      bf16x8 af[4];
#pragma unroll
      for (int ks = 0; ks < 4; ++ks) af[ks] = *(const LAS bf16x8*)(Ab + 64 * ks);
#pragma unroll
      for (int ct = 0; ct < 4; ++ct) { f32x4 r = (f32x4){0.f, 0.f, 0.f, 0.f};
          const LAS unsigned char* Bb = kb + (ct * 16 + cc) * 272 + 16 * q;
#pragma unroll
          for (int ks = 0; ks < 4; ++ks) r = MFMA16(af[ks], *(const LAS bf16x8*)(Bb + 64 * ks), r);
          const int j = ct * 16 + cc; const float gj = sc[j];
#pragma unroll
          for (int e = 0; e < 4; ++e) { const int i = rt * 16 + 4 * q + e; const float gi = sc[i];
              if (!isqk) { Am[i * 64 + j] = (i > j) ? r[e] * sc[64 + i] * __expf(gi - gj) : 0.f; }
              else { const float v = (i >= j) ? r[e] * 0.08838834764831845f * __expf(gi - gj) : 0.f;
                  ((bf16*)(argws() + WS_OB))[((size_t)(c * 8 + h) * 64 + i) * 64 + j] = (unsigned short)(pk2(v, 0.f) & 0xffffu); } } } }
    __syncthreads();
    if (tid < 256) { const int cl = tid; float s[64];
        if (cl < 128) {
#pragma unroll
            for (int i = 0; i < 64; ++i) s[i] = bf2f(*(const LAS unsigned short*)(vb + i * 272 + cl * 2)) * sc[64 + i];
        } else {
#pragma unroll
            for (int i = 0; i < 64; ++i) s[i] = bf2f(*(const LAS unsigned short*)(kb + i * 272 + (cl - 128) * 2)) * sc[64 + i] * sc[128 + i];
        }
#pragma unroll
        for (int i = 1; i < 64; ++i) { float acc = s[i];
#pragma unroll
            for (int j4 = 0; j4 < (i + 3) / 4; ++j4) { const f32x4 av = *(const LAS f32x4*)(Am + i * 64 + 4 * j4);
#pragma unroll
                for (int e = 0; e < 4; ++e) if (4 * j4 + e < i) acc -= av[e] * s[4 * j4 + e]; }
            s[i] = acc; }
        if (cl < 128) { bf16* dst = QKV + (size_t)(c * 64) * QKVW + 2048 + h * 128 + cl;
#pragma unroll
            for (int i = 0; i < 64; ++i) dst[(size_t)i * QKVW] = (unsigned short)(pk2(s[i], 0.f) & 0xffffu); }
        else { bf16* dst = (bf16*)(argws() + WS_XB) + (size_t)(c * 64) * D + h * 128 + (cl - 128);
#pragma unroll
            for (int i = 0; i < 64; ++i) dst[(size_t)i * D] = (unsigned short)(pk2(s[i], 0.f) & 0xffffu); }
    } else { const int t2 = tid - 256; const float glast = sc[63];
        { const int i = t2 >> 2, sg = t2 & 3; const float f = sc[128 + i] * 0.08838834764831845f;
          const LAS u32x4* src = (const LAS u32x4*)(qb + i * 272 + sg * 64); u32x4* dst = (u32x4*)(QKV + (size_t)(c * 64 + i) * QKVW + h * 128 + sg * 32);
#pragma unroll
          for (int p = 0; p < 4; ++p) { const u32x4 v = src[p]; u32x4 o;
#pragma unroll
              for (int e = 0; e < 4; ++e) o[e] = pk2(bflo(v[e]) * f, bfhi(v[e]) * f);
              dst[p] = o; } }
        { const int rr = t2 >> 1, hfj = t2 & 1;
          bf16* dst = QKV + (size_t)(c * 64 + (rr >> 1)) * QKVW + 1024 + h * 128 + (rr & 1) * 64 + hfj * 32;
#pragma unroll
          for (int p = 0; p < 4; ++p) { u32x4 o;
#pragma unroll
              for (int e = 0; e < 4; ++e) { const int j0 = hfj * 32 + p * 8 + 2 * e;
                  const float k0 = bf2f(*(const LAS unsigned short*)(kb + j0 * 272 + rr * 2)) * __expf(glast - sc[j0]);
                  const float k1 = bf2f(*(const LAS unsigned short*)(kb + (j0 + 1) * 272 + rr * 2)) * __expf(glast - sc[j0 + 1]);
                  o[e] = pk2(k0, k1); }
              *(u32x4*)(dst + p * 8) = o; } } }
    __syncthreads();
}

constexpr int DS_W = 0, DS_QG = 17408, DS_KD = 34816, DS_QK = 53248, DS_U = 62464, DS_BUF = 64512;
__device__ __forceinline__ void dn_scan_worker(LAS unsigned char* lds, int worker) {
    int tid_l = threadIdx.x; asm volatile("" : "+v"(tid_l));
    const int h = worker >> 3, sl = worker & 7, tid = tid_l, lane = tid & 63, wid = tid >> 6;
    bf16* QKV = (bf16*)(argws() + WS_BIG); const bf16* Wr = (const bf16*)(argws() + WS_XB); const bf16* QKr = (const bf16*)(argws() + WS_OB);
    const float* DEC = (const float*)(argws() + WS_DECAY);
    u32x4 pre[8];
    auto src_of = [&](int p, int c, int& dst) -> const u32x4* {
        if (p < 1024) { const int row = p >> 4, chn = p & 15; dst = DS_W + row * 272 + chn * 16; return (const u32x4*)(Wr + (size_t)(c * 64 + row) * D + h * 128) + chn; }
        if (p < 2048) { const int pp = p - 1024, row = pp >> 4, chn = pp & 15; dst = DS_QG + row * 272 + chn * 16; return (const u32x4*)(QKV + (size_t)(c * 64 + row) * QKVW + h * 128) + chn; }
        if (p < 3072) { const int pp = p - 2048, seg = pp >> 4, chn = pp & 15; dst = DS_KD + (2 * seg + (chn >> 3)) * 144 + (chn & 7) * 16; return (const u32x4*)(QKV + (size_t)(c * 64 + seg) * QKVW + 1024 + h * 128) + chn; }
        if (p < 3584) { const int pp = p - 3072, row = pp >> 3, chn = pp & 7; dst = DS_QK + row * 144 + chn * 16; return (const u32x4*)(QKr + ((size_t)(c * 8 + h) * 64 + row) * 64) + chn; }
        { const int pp = p - 3584, row = pp >> 1, chn = pp & 1; dst = DS_U + row * 32 + chn * 16; return (const u32x4*)(QKV + (size_t)(c * 64 + row) * QKVW + 2048 + h * 128 + sl * 16) + chn; }
    };
#define DN_LOAD(c) do { _Pragma("unroll") for (int i_ = 0; i_ < 8; ++i_) { const int p_ = tid + 512 * i_; if (p_ < 3712) { int d_; const u32x4* s_ = src_of(p_, (c), d_); pre[i_] = *s_; } } } while (0)
#define DN_STORE(bufo) do { _Pragma("unroll") for (int i_ = 0; i_ < 8; ++i_) { const int p_ = tid + 512 * i_; if (p_ < 3712) { int d_; (void)src_of(p_, 0, d_); *(LAS u32x4*)(lds + (bufo) + d_) = pre[i_]; } } } while (0)
    DN_LOAD(0); DN_STORE(0);
    __syncthreads();
    f32x4 Sacc[8];
#pragma unroll
    for (int i = 0; i < 8; ++i) Sacc[i] = (f32x4){0.f, 0.f, 0.f, 0.f};
    const int cc = lane & 15, q = lane >> 4;
    for (int c = 0; c < 256; ++c) {
        const int bo = (c & 1) * DS_BUF;
        if (c + 1 < 256) DN_LOAD(c + 1);
        if (wid == 0) {
            const LAS unsigned char* B = lds + bo;
            bf16x8 Sb[4];
#pragma unroll
            for (int ks = 0; ks < 4; ++ks) Sb[ks] = pack8(Sacc[2 * ks], Sacc[2 * ks + 1]);
            f32x4 wS[4], oa[4];
#pragma unroll
            for (int T = 0; T < 4; ++T) { wS[T] = (f32x4){0.f, 0.f, 0.f, 0.f}; oa[T] = wS[T];
#pragma unroll
                for (int ks = 0; ks < 4; ++ks) {
                    const LAS unsigned char* wp = B + DS_W + (16 * T + cc) * 272 + (32 * ks + 4 * q) * 2;
                    const bf16x8 wf = __builtin_shufflevector(*(const LAS s16x4*)wp, *(const LAS s16x4*)(wp + 32), 0, 1, 2, 3, 4, 5, 6, 7);
                    wS[T] = MFMA16(wf, Sb[ks], wS[T]);
                    const LAS unsigned char* qp = B + DS_QG + (16 * T + cc) * 272 + (32 * ks + 4 * q) * 2;
                    const bf16x8 qf = __builtin_shufflevector(*(const LAS s16x4*)qp, *(const LAS s16x4*)(qp + 32), 0, 1, 2, 3, 4, 5, 6, 7);
                    oa[T] = MFMA16(qf, Sb[ks], oa[T]); } }
            f32x4 vn[4];
#pragma unroll
            for (int T = 0; T < 4; ++T)
#pragma unroll
                for (int e = 0; e < 4; ++e) { const int row = 16 * T + 4 * q + e; vn[T][e] = bf2f(*(const LAS unsigned short*)(B + DS_U + row * 32 + cc * 2)) - wS[T][e]; }
            bf16x8 vbf[2]; vbf[0] = pack8(vn[0], vn[1]); vbf[1] = pack8(vn[2], vn[3]);
#pragma unroll
            for (int T = 0; T < 4; ++T)
#pragma unroll
                for (int k2 = 0; k2 < 2; ++k2) { const LAS unsigned char* pp = B + DS_QK + (16 * T + cc) * 144 + (32 * k2 + 4 * q) * 2;
                    const bf16x8 pf = __builtin_shufflevector(*(const LAS s16x4*)pp, *(const LAS s16x4*)(pp + 32), 0, 1, 2, 3, 4, 5, 6, 7);
                    oa[T] = MFMA16(pf, vbf[k2], oa[T]); }
            bf16* orow = QKV + (size_t)(c * 64) * QKVW + 2048 + h * 128 + sl * 16 + cc;
#pragma unroll
            for (int T = 0; T < 4; ++T)
#pragma unroll
                for (int e = 0; e < 4; ++e) orow[(size_t)(16 * T + 4 * q + e) * QKVW] = (unsigned short)(pk2(oa[T][e], 0.f) & 0xffffu);
            const float dl = DEC[c * 8 + h];
#pragma unroll
            for (int R = 0; R < 8; ++R) { Sacc[R] = Sacc[R] * dl;
#pragma unroll
                for (int k2 = 0; k2 < 2; ++k2) { const LAS unsigned char* kp = B + DS_KD + (16 * R + cc) * 144 + (32 * k2 + 4 * q) * 2;
                    const bf16x8 kf = __builtin_shufflevector(*(const LAS s16x4*)kp, *(const LAS s16x4*)(kp + 32), 0, 1, 2, 3, 4, 5, 6, 7);
                    Sacc[R] = MFMA16(kf, vbf[k2], Sacc[R]); } }
        }
        if (c + 1 < 256) DN_STORE(((c + 1) & 1) * DS_BUF);
        __syncthreads();
    }
#undef DN_LOAD
#undef DN_STORE
}

__global__ void __launch_bounds__(512, 2) mk_fwd(Args a) {
    extern __shared__ __attribute__((aligned(16))) unsigned char lds_raw[];
    LAS unsigned char* lds = (LAS unsigned char*)lds_raw;
    cg::grid_group grid = cg::this_grid();
    const int G = gridDim.x, bx = blockIdx.x, NGW = G * 8;
#define PH_VARS int tid_l = threadIdx.x; asm volatile("" : "+v"(tid_l)); const int lane = tid_l & 63, wave = __builtin_amdgcn_readfirstlane(tid_l >> 6), gw = bx * 8 + wave; \
    LAS float* scr = (LAS float*)(lds + wave * 16384); unsigned char* ws = argws(); float* X = argout(); bf16* XB = (bf16*)(ws + WS_XB); bf16* OB = (bf16*)(ws + WS_OB); float* SSQ = (float*)(ws + WS_SSQ); \
    (void)X; (void)XB; (void)OB; (void)SSQ; (void)scr; (void)lane; (void)gw;

    {   PH_VARS
        for (int l = 0; l < 2; ++l) {
            unsigned char* tb = ws + WS_BIG + (size_t)l * 8 * MiB;
            TJ_RUN(argin(9) + (size_t)l * D * 2048, D, 2048, (bf16*)tb, argin(7) + l * D, 0);
            TJ_RUN(argin(10) + (size_t)l * D * D, D, D, (bf16*)(tb + 6 * MiB), (const float*)nullptr, 0);
            const float* Wq = argin(8) + (size_t)l * D * D; const float* gx = argin(6) + l * D; bf16* WQG = (bf16*)(tb + 4 * MiB);
            for (int i = gw * 64 + lane; i < D * D / 4; i += NGW * 64) { const f32x4 v = ((const f32x4*)Wq)[i]; const float g = gx[(i * 4) >> 10] * 0.0625f;
                u32x2 w; w.x = pk2(v[0] * g, v[1] * g); w.y = pk2(v[2] * g, v[3] * g); ((u32x2*)WQG)[i] = w; }
        }
    }
    {   PH_VARS
        for (int m = gw; m < NMEM; m += NGW) { const f32x4* xr = (const f32x4*)(argin(1) + (size_t)m * D) + lane; float s = 0.f; f32x4 v[4];
#pragma unroll
            for (int j = 0; j < 4; ++j) { v[j] = xr[64 * j]; s += (v[j][0] * v[j][0] + v[j][1] * v[j][1]) + (v[j][2] * v[j][2] + v[j][3] * v[j][3]); }
            s = wave_sum(s); u32x2* o = (u32x2*)((bf16*)(ws + WS_MEMB) + (size_t)m * D) + lane;
#pragma unroll
            for (int j = 0; j < 4; ++j) { u32x2 w; w.x = pk2(v[j][0], v[j][1]); w.y = pk2(v[j][2], v[j][3]); o[64 * j] = w; }
            if (lane == 0) ((float*)(ws + WS_MEMRS))[m] = rsqrtf(s * (1.f / 1024.f) + EPS); }
        for (int m = gw; m < S; m += NGW) { const f32x4* xr = (const f32x4*)(argin(0) + (size_t)m * D) + lane; float s = 0.f; f32x4 v[4];
#pragma unroll
            for (int j = 0; j < 4; ++j) { v[j] = xr[64 * j]; s += (v[j][0] * v[j][0] + v[j][1] * v[j][1]) + (v[j][2] * v[j][2] + v[j][3] * v[j][3]); }
            s = wave_sum(s); u32x2* o = (u32x2*)(XB + (size_t)m * D) + lane; f32x4* xo = (f32x4*)(X + (size_t)m * D) + lane;
#pragma unroll
            for (int j = 0; j < 4; ++j) { u32x2 w; w.x = pk2(v[j][0], v[j][1]); w.y = pk2(v[j][2], v[j][3]); o[64 * j] = w; xo[64 * j] = v[j]; }
            if (lane < 16) SSQ[(size_t)m * 16 + lane] = lane == 0 ? s : 0.f; }
    }
    { PH_VARS layer_weights(0, gw, NGW, scr, lane); }
    grid.sync();
    { PH_VARS pg8::KvSched Sd{G, bx, ws}; pg8::EpiPrep<0> E{ws}; pg8::gemm_phase(lds, 1024, 1024, 1024, Sd, E); }
    grid.sync();
    { PH_VARS pg8::QkSched Sd{G, bx, ws}; pg8::EpiPrep<1> E{ws}; pg8::gemm_phase(lds, 2048, 1024, 256, Sd, E); }
    { PH_VARS pg8::VoSched Sd{G, (bx + G / 2) % G, ws}; pg8::EpiPrep<2> E{ws}; pg8::gemm_phase(lds, 1024, 2048, 256, Sd, E); }
    grid.sync();

    for (int l = 0; l < 2; ++l) {
        if (l == 1) { { PH_VARS layer_weights(1, gw, NGW, scr, lane); } grid.sync(); }
        { PH_VARS pg8::TileSched Sd; Sd.init(S, 2 * FF, G, bx, XB, D, ws + WS_F1IN, D); pg8::EpiSwiGLU E{(bf16*)(ws + WS_BIG), SSQ, (LAS float*)(lds + RED_OFF + 8192)}; pg8::gemm_phase(lds, D, D, D, Sd, E); }
        grid.sync();
        { PH_VARS pg8::TileSched Sd; Sd.init(S, D, G, bx, ws + WS_BIG, FF, ws + WS_F1OUT, FF); pg8::EpiResid E{X, XB, SSQ, 0.5f}; pg8::gemm_phase(lds, FF, FF, FF, Sd, E); }
        grid.sync();
        if (l == 0) {
            { PH_VARS pg8::TileSched Sd; Sd.init(S, ABN, G, bx, XB, D, ws + WS_MIXIN, D); pg8::EpiBf16 E{(bf16*)(ws + WS_BIG), ABN, SSQ, 1, 1.f, (LAS float*)(lds + RED_OFF + 8192)}; pg8::gemm_phase(lds, D, D, D, Sd, E); }
            grid.sync();
#ifndef NO_LRU
            for (int u = bx; u < 2048; u += G) lru_local_unit((LAS float*)lds, u);
#endif
            __syncthreads();
#ifndef NO_ATTN
            { PH_VARS for (int u = gw; u < 8192; u += NGW) attn_unit((const bf16*)(ws + WS_BIG), OB, lds + wave * 5120, u, lane); }
#endif
            grid.sync();
#ifndef NO_LRU
            for (int u = bx; u < 2048; u += G) lru_apply_unit((LAS float*)lds, u);
#endif
            grid.sync();
        } else {
            { PH_VARS pg8::TileSched Sd; Sd.init(S, DNN, G, bx, XB, D, ws + WS_MIXIN, D);
              pg8::EpiDN E{(bf16*)(ws + WS_BIG), (bf16*)(ws + WS_BIG + 96 * MiB), (bf16*)(ws + WS_HALO), (float*)(ws + WS_DNAB), SSQ, argin(25), argin(26), (LAS float*)(lds + RED_OFF + 8192)}; pg8::gemm_phase(lds, D, D, D, Sd, E); }
            grid.sync();
#ifndef NO_DNL
            for (int u = bx; u < 2048; u += G) dn_local_unit(lds, u);
#endif
            grid.sync();
#ifndef NO_DNS
            if (bx < 64) dn_scan_worker(lds, bx);
#endif
            grid.sync();
            {   PH_VARS
                const bf16* QKV = (const bf16*)(ws + WS_BIG); const bf16* Z = (const bf16*)(ws + WS_BIG + 96 * MiB); const float* gn = argin(27);
                for (int m = gw; m < S; m += NGW) { const u32x4* op = (const u32x4*)(QKV + (size_t)m * QKVW + 2048 + lane * 16); const u32x4* zp = (const u32x4*)(Z + (size_t)m * D + lane * 16);
                    const u32x4 o0 = op[0], o1 = op[1], z0 = zp[0], z1 = zp[1]; float ov[16], zv[16]; float ss = 0.f;
#pragma unroll
                    for (int e = 0; e < 4; ++e) { ov[2 * e] = bflo(o0[e]); ov[2 * e + 1] = bfhi(o0[e]); ov[8 + 2 * e] = bflo(o1[e]); ov[9 + 2 * e] = bfhi(o1[e]);
                        zv[2 * e] = bflo(z0[e]); zv[2 * e + 1] = bfhi(z0[e]); zv[8 + 2 * e] = bflo(z1[e]); zv[9 + 2 * e] = bfhi(z1[e]); }
#pragma unroll
                    for (int e = 0; e < 16; ++e) ss += ov[e] * ov[e];
                    ss += __shfl_xor(ss, 1); ss += __shfl_xor(ss, 2); ss += __shfl_xor(ss, 4);
                    const float rs = rsqrtf(ss * (1.f / 128.f) + EPS); const float* gp = gn + (lane & 7) * 16; float y[16];
#pragma unroll
                    for (int e = 0; e < 16; ++e) y[e] = ov[e] * rs * gp[e] * siluf_(zv[e]);
                    u32x4 w0, w1;
#pragma unroll
                    for (int e = 0; e < 4; ++e) { w0[e] = pk2(y[2 * e], y[2 * e + 1]); w1[e] = pk2(y[8 + 2 * e], y[9 + 2 * e]); }
                    u32x4* dp = (u32x4*)(OB + (size_t)m * D + lane * 16); dp[0] = w0; dp[1] = w1; }
            }
            grid.sync();
        }
        { PH_VARS pg8::TileSched Sd; Sd.init(S, D, G, bx, OB, D, ws + WS_MIXOUT, D); pg8::EpiResid E{X, XB, SSQ, 1.0f}; pg8::gemm_phase(lds, D, D, D, Sd, E); }
        grid.sync();
        { PH_VARS pg8::TileSched Sd; Sd.init(S, D, G, bx, XB, D, ws + WS_WQK + (size_t)l * 2 * MiB, D); pg8::EpiSoftmax E{(bf16*)(ws + WS_BIG), SSQ, (LAS float*)(lds + RED_OFF)}; pg8::gemm_phase(lds, D, D, D, Sd, E); }
        grid.sync();
        { PH_VARS pg8::TileSched Sd; Sd.init(S, D, G, bx, ws + WS_BIG, D, ws + WS_WVO + (size_t)l * 2 * MiB, D); pg8::EpiResid E{X, XB, SSQ, 1.0f}; pg8::gemm_phase(lds, D, D, D, Sd, E); }
        grid.sync();
        { PH_VARS pg8::TileSched Sd; Sd.init(S, 2 * FF, G, bx, XB, D, ws + WS_F2IN, D); pg8::EpiSwiGLU E{(bf16*)(ws + WS_BIG), SSQ, (LAS float*)(lds + RED_OFF + 8192)}; pg8::gemm_phase(lds, D, D, D, Sd, E); }
        grid.sync();
        { PH_VARS pg8::TileSched Sd; Sd.init(S, D, G, bx, ws + WS_BIG, FF, ws + WS_F2OUT, FF); pg8::EpiResid E{X, XB, SSQ, 0.5f}; pg8::gemm_phase(lds, FF, FF, FF, Sd, E); }
        grid.sync();
    }
    { PH_VARS const float* gf = argin(29);
      for (int m = gw; m < S; m += NGW) { const float rs = row_rstd16(SSQ, m); f32x4* xr = (f32x4*)(X + (size_t)m * D) + lane; const f32x4* gp = (const f32x4*)gf + lane;
#pragma unroll
          for (int j = 0; j < 4; ++j) { const f32x4 v = xr[64 * j], g = gp[64 * j]; xr[64 * j] = v * rs * g; } } }
}

extern "C" void kernel_launch(void* const* d_in, const int* in_sizes, int n_in, void* d_out, int out_size, void* d_ws, size_t ws_size, hipStream_t stream) {
    static int grid = 0;
    if (grid == 0) {
        if (n_in != 30 || out_size != S * D || ws_size < WS_END) { fprintf(stderr, "kernel_launch: unexpected shapes (n_in %d out %d ws %zu)\n", n_in, out_size, ws_size); grid = -1; return; }
        int dev = 0, cus = 0, per_cu = 0;
        hipGetDevice(&dev); hipDeviceGetAttribute(&cus, hipDeviceAttributeMultiprocessorCount, dev);
        hipFuncSetAttribute((const void*)mk_fwd, hipFuncAttributeMaxDynamicSharedMemorySize, LDS_BYTES);
        hipOccupancyMaxActiveBlocksPerMultiprocessor(&per_cu, (const void*)mk_fwd, 512, LDS_BYTES);
        if (per_cu < 1) { fprintf(stderr, "kernel_launch: occupancy query says %d blocks per CU\n", per_cu); per_cu = 1; }
        grid = cus * 1;
        (void)hipGetLastError();
    }
    if (grid < 0) return;
    Args a{};
    for (int i = 0; i < 30; ++i) a.in[i] = (const float*)d_in[i];
    a.out = (float*)d_out; a.ws = (unsigned char*)d_ws;
    void* args[] = {&a};
    hipError_t e = hipLaunchCooperativeKernel((const void*)mk_fwd, dim3(grid), dim3(512), args, LDS_BYTES, stream);
    if (e != hipSuccess) fprintf(stderr, "cooperative launch failed: %s (grid %d)\n", hipGetErrorString(e), grid);
}
```

```cpp
#include <hip/hip_runtime.h>
#include <hip/hip_cooperative_groups.h>
#include <cstdio>
#include <cstdint>
namespace cg = cooperative_groups;

#define LAS __attribute__((address_space(3)))
typedef unsigned short bf16;
typedef short bf16x8 __attribute__((ext_vector_type(8)));
typedef short s16x4 __attribute__((ext_vector_type(4)));
typedef float f32x4 __attribute__((ext_vector_type(4)));
typedef float f32x2 __attribute__((ext_vector_type(2)));
typedef unsigned u32x4 __attribute__((ext_vector_type(4)));
typedef unsigned u32x2 __attribute__((ext_vector_type(2)));
typedef __bf16 bf16x2_t __attribute__((ext_vector_type(2)));

constexpr int S = 16384, D = 1024, FF = 2816, NMEM = 256;
constexpr int ABN = 2560, DNN = 4352, DNREAL = 4112, QKVW = 3072;
constexpr float EPS = 1e-6f;
constexpr size_t MiB = 1u << 20;
constexpr size_t WS_SSQ = 1 * MiB;
constexpr size_t WS_DNAB = 2 * MiB;
constexpr size_t WS_MEMB = 3 * MiB;
constexpr size_t WS_MEMRS = 3 * MiB + 512 * 1024;
constexpr size_t WS_DECAY = 3 * MiB + 768 * 1024;
constexpr size_t WS_LRUTOT = 4 * MiB;
constexpr size_t WS_HALO = 5 * MiB;
constexpr size_t WS_KV = 10 * MiB;
constexpr size_t WS_WQK = 12 * MiB;
constexpr size_t WS_WVO = 16 * MiB;
constexpr size_t WS_F1IN = 20 * MiB, WS_F1OUT = 31 * MiB, WS_F2IN = WS_F1OUT + 5 * MiB + 512 * 1024, WS_F2OUT = WS_F2IN + 11 * MiB;
constexpr size_t WS_MIXIN = 53 * MiB, WS_MIXOUT = WS_MIXIN + 8 * MiB + 512 * 1024;
constexpr size_t WS_XB = 64 * MiB;
constexpr size_t WS_OB = 96 * MiB;
constexpr size_t WS_BIG = 128 * MiB;
constexpr size_t WS_END = 256 * MiB;
static_assert(WS_F2OUT + 5 * MiB + 512 * 1024 <= WS_MIXIN && WS_MIXOUT + 2 * MiB <= WS_XB, "weights map");

constexpr int LDS_BYTES = 147456;
constexpr int RED_OFF = 131072;

__device__ __forceinline__ unsigned pk2(float lo, float hi) { f32x2 v = {lo, hi}; bf16x2_t b = __builtin_convertvector(v, bf16x2_t); return __builtin_bit_cast(unsigned, b); }
__device__ __forceinline__ float bf2f(unsigned short b) { return __uint_as_float(((unsigned)b) << 16); }
__device__ __forceinline__ float bflo(unsigned w) { return __uint_as_float(w << 16); }
__device__ __forceinline__ float bfhi(unsigned w) { return __uint_as_float(w & 0xffff0000u); }
__device__ __forceinline__ float sigmoidf_(float x) { return __builtin_amdgcn_rcpf(1.f + __expf(-x)); }
__device__ __forceinline__ float siluf_(float x) { return x * sigmoidf_(x); }
__device__ __forceinline__ float softplusf_(float x) { return x > 20.f ? x : log1pf(__expf(x)); }
__device__ __forceinline__ float gelu_tanh(float x) { const float u = 0.7978845608f * (x + 0.044715f * x * x * x); const float t = 1.f - 2.f * __builtin_amdgcn_rcpf(__expf(2.f * u) + 1.f); return 0.5f * x * (1.f + t); }
__device__ __forceinline__ float row_rstd16(const float* ssq, int row) {
    const f32x4* p = (const f32x4*)(ssq + (size_t)row * 16); const f32x4 a = p[0], b = p[1], c = p[2], d = p[3];
    const float s = ((a[0] + a[1]) + (a[2] + a[3])) + ((b[0] + b[1]) + (b[2] + b[3])) + ((c[0] + c[1]) + (c[2] + c[3])) + ((d[0] + d[1]) + (d[2] + d[3]));
    return rsqrtf(s * (1.f / 1024.f) + EPS);
}
__device__ __forceinline__ bf16x8 pack8(const f32x4& a, const f32x4& b) { u32x4 p; p[0] = pk2(a[0], a[1]); p[1] = pk2(a[2], a[3]); p[2] = pk2(b[0], b[1]); p[3] = pk2(b[2], b[3]); return __builtin_bit_cast(bf16x8, p); }

__device__ __forceinline__ float qred_max(float t) {
    auto r = __builtin_amdgcn_permlane16_swap(__float_as_uint(t), __float_as_uint(t), false, false);
    t = fmaxf(__uint_as_float(r[0]), __uint_as_float(r[1]));
    auto r2 = __builtin_amdgcn_permlane32_swap(__float_as_uint(t), __float_as_uint(t), false, false);
    return fmaxf(__uint_as_float(r2[0]), __uint_as_float(r2[1]));
}
__device__ __forceinline__ float qred_sum(float t) {
    auto r = __builtin_amdgcn_permlane16_swap(__float_as_uint(t), __float_as_uint(t), false, false);
    t = __uint_as_float(r[0]) + __uint_as_float(r[1]);
    auto r2 = __builtin_amdgcn_permlane32_swap(__float_as_uint(t), __float_as_uint(t), false, false);
    return __uint_as_float(r2[0]) + __uint_as_float(r2[1]);
}
#define MFMA16(a, b, c) __builtin_amdgcn_mfma_f32_16x16x32_bf16((a), (b), (c), 0, 0, 0)

namespace pg8 {
constexpr int BM = 256, BK = 64, HALF = 128, HTB = HALF * BK * 2, NXCD = 8, WGM = 8;
__host__ __device__ __forceinline__ int lds_byte(int r, int c) { const int st = (r >> 4) * 2 + (c >> 5), rr = r & 15, cc = c & 31, ob = rr * 64 + cc * 2; return st * 1024 + (ob ^ (((ob >> 9) & 1) << 5)); }
__host__ __device__ __forceinline__ void stage_rc(int b, int& R, int& C) { const int st = b / 1024, sb = b % 1024, swz = sb ^ (((sb >> 9) & 1) << 5); R = (st >> 1) * 16 + swz / 64; C = (st & 1) * 32 + (swz % 64) / 2; }
__host__ __device__ __forceinline__ int perm32(int rho) { const int n = rho >> 4, i = rho & 15; return 8 * (i >> 2) + 4 * n + (i & 3); }

struct Unit { int pm, pn; const char* a; const char* b; int aux; };

struct TileSched {
    int nM, nN, nwg, G, c; const char* A; const char* B; size_t tA, tB;
    __device__ void init(int M, int N, int G_, int c_, const void* A_, int lda, const void* B_, int ldb) { nM = M / BM; nN = N / BM; nwg = nM * nN; G = G_; c = c_; A = (const char*)A_; B = (const char*)B_; tA = (size_t)BM * lda * 2; tB = (size_t)BM * ldb * 2; }
    __device__ bool next(int i, Unit& u) const {
        const long L = (long)i * G + c; if (L >= nwg) return false;
        int wgid = (int)L; { const int q = nwg / NXCD, r = nwg % NXCD, xcd = wgid % NXCD, off = wgid / NXCD; wgid = (xcd < r ? xcd * (q + 1) : r * (q + 1) + (xcd - r) * q) + off; }
        const int nig = WGM * nN, gid = wgid / nig, fm = gid * WGM, gsz = (nM - fm) < WGM ? (nM - fm) : WGM;
        u.pm = fm + ((wgid % nig) % gsz); u.pn = (wgid % nig) / gsz; u.a = A + (size_t)u.pm * tA; u.b = B + (size_t)u.pn * tB; u.aux = i; return true;
    }
};

template <class Epi, class Sched>
__device__ __forceinline__ void gemm_phase(LAS unsigned char* lds, const int lda, const int ldb, const int K, const Sched& S, const Epi& E) {
    int tid_ = threadIdx.x; asm volatile("" : "+v"(tid_));
    const int tid = tid_, wid = __builtin_amdgcn_readfirstlane(tid >> 6), lane = tid & 63, wr = wid >> 2, wc = wid & 3, fr = lane & 15, fq = lane >> 4;
    int Kv_ = K; asm volatile("" : "+s"(Kv_));
    const int nt = Kv_ / BK;
    unsigned voffA[2], voffB[2];
#pragma unroll
    for (int i = 0; i < 2; ++i) { int R, C; stage_rc(tid * 16 + i * 8192, R, C); const int Rb = Epi::PERM ? ((R & ~31) + perm32(R & 31)) : R;
        voffA[i] = (unsigned)(R * lda + C) * 2u; voffB[i] = (unsigned)(Rb * ldb + C) * 2u; }
    const size_t kstep = (size_t)(BK * 2);
    const size_t hstepA = (size_t)HALF * lda * 2, hstepB = (size_t)HALF * ldb * 2;
    const unsigned ldsw = (unsigned)wid * 1024u;
    const int aoff = lds_byte(wr * 64 + fr, fq * 8), boff = lds_byte(wc * 32 + fr, fq * 8);
#define PG8_SA(b, h) (((b) * 2 + (h)) * HTB)
#define PG8_SB(b, h) ((4 + (b) * 2 + (h)) * HTB)
#define PG8_STAGE(bufoff, gbase, voff) do { _Pragma("unroll") for (int _i = 0; _i < 2; ++_i) \
        __builtin_amdgcn_global_load_lds((const unsigned*)((const char*)(gbase) + (voff)[_i]), (LAS unsigned*)(lds + (bufoff) + ldsw + _i * 8192), 16, 0, 0); } while (0)
#define PG8_LDA(dst, b, h) do { _Pragma("unroll") for (int m = 0; m < 4; ++m) _Pragma("unroll") for (int k = 0; k < 2; ++k) dst[m][k] = *(const LAS bf16x8*)(lds + PG8_SA(b, h) + aoff + m * 2048 + k * 1024); } while (0)
#define PG8_LDB(dst, b, h) do { _Pragma("unroll") for (int n = 0; n < 2; ++n) _Pragma("unroll") for (int k = 0; k < 2; ++k) dst[n][k] = *(const LAS bf16x8*)(lds + PG8_SB(b, h) + boff + n * 2048 + k * 1024); } while (0)
#define PG8_MMA(ai, bj, At, Bt) do { __builtin_amdgcn_s_setprio(1); _Pragma("unroll") for (int m = 0; m < 4; ++m) _Pragma("unroll") for (int n = 0; n < 2; ++n) _Pragma("unroll") for (int k = 0; k < 2; ++k) \
        acc[ai][bj][m][n] = __builtin_amdgcn_mfma_f32_16x16x32_bf16(Bt[n][k], At[m][k], acc[ai][bj][m][n], 0, 0, 0); __builtin_amdgcn_s_setprio(0); } while (0)
#define PG8_WAIT_V(n) asm volatile("s_waitcnt vmcnt(" #n ")" ::: "memory")
#define PG8_WAIT_L(n) asm volatile("s_waitcnt lgkmcnt(" #n ")" ::: "memory")
#define PG8_BAR __builtin_amdgcn_s_barrier()
#define PG8_SCHED __builtin_amdgcn_sched_barrier(0)
    Unit cur, nxt; int ui = 0;
    if (!S.next(0, cur)) return;
    f32x4 acc[2][2][4][2];
#pragma unroll
    for (int a = 0; a < 2; ++a)
#pragma unroll
        for (int b = 0; b < 2; ++b)
#pragma unroll
            for (int m = 0; m < 4; ++m)
#pragma unroll
                for (int n = 0; n < 2; ++n) acc[a][b][m][n] = (f32x4){0.f, 0.f, 0.f, 0.f};
    bf16x8 At[4][2], B0[2][2], B1[2][2];
    const char* cA = cur.a; const char* cB = cur.b;
    PG8_STAGE(PG8_SB(0, 0), cB, voffB); PG8_STAGE(PG8_SB(0, 1), cB + hstepB, voffB); PG8_STAGE(PG8_SA(0, 0), cA, voffA); PG8_STAGE(PG8_SA(0, 1), cA + hstepA, voffA);
    if (wr == 1) PG8_BAR;
    PG8_WAIT_V(2); PG8_BAR;
    PG8_STAGE(PG8_SB(1, 0), cB + kstep, voffB); PG8_STAGE(PG8_SA(1, 0), cA + kstep, voffA); PG8_STAGE(PG8_SB(1, 1), cB + hstepB + kstep, voffB);
    PG8_WAIT_V(6); PG8_BAR;
    for (;;) {
        const bool has_next = S.next(ui + 1, nxt);
        const char* nA = has_next ? nxt.a : cA; const char* nB = has_next ? nxt.b : cB;
        for (int t = 0; t < nt; t += 2) {
            const bool last = (t == nt - 2);
            const char* a1 = cA + (size_t)(t + 1) * kstep;
            const char* a2 = last ? nA : cA + (size_t)(t + 2) * kstep; const char* b2 = last ? nB : cB + (size_t)(t + 2) * kstep;
            const char* a3 = a2 + kstep; const char* b3 = b2 + kstep;
            PG8_LDB(B0, 0, 0); PG8_LDB(B1, 0, 1); PG8_SCHED; PG8_LDA(At, 0, 0); PG8_STAGE(PG8_SA(1, 1), a1 + hstepA, voffA);
            PG8_WAIT_V(8); PG8_WAIT_L(0); PG8_BAR; PG8_MMA(0, 0, At, B0); PG8_MMA(0, 1, At, B1); PG8_BAR; PG8_SCHED;
            PG8_LDA(At, 0, 1); PG8_STAGE(PG8_SB(0, 0), b2, voffB); PG8_STAGE(PG8_SB(0, 1), b2 + hstepB, voffB); PG8_STAGE(PG8_SA(0, 0), a2, voffA);
            PG8_WAIT_V(8); PG8_WAIT_L(0); PG8_BAR; PG8_MMA(1, 0, At, B0); PG8_MMA(1, 1, At, B1); PG8_BAR; PG8_SCHED;
            PG8_LDB(B0, 1, 0); PG8_LDB(B1, 1, 1); PG8_SCHED; PG8_LDA(At, 1, 0); PG8_STAGE(PG8_SA(0, 1), a2 + hstepA, voffA);
            PG8_WAIT_V(8); PG8_WAIT_L(0); PG8_BAR; PG8_MMA(0, 0, At, B0); PG8_MMA(0, 1, At, B1); PG8_BAR; PG8_SCHED;
            PG8_LDA(At, 1, 1); PG8_STAGE(PG8_SB(1, 0), b3, voffB); PG8_STAGE(PG8_SB(1, 1), b3 + hstepB, voffB); PG8_STAGE(PG8_SA(1, 0), a3, voffA);
            PG8_WAIT_V(8); PG8_WAIT_L(0); PG8_BAR; PG8_MMA(1, 0, At, B0); PG8_MMA(1, 1, At, B1); PG8_BAR; PG8_SCHED;
        }
        if (wr == 0) PG8_BAR;
        E(acc, cur, wr, wc, fr, fq);
        if (!has_next) break;
#pragma unroll
        for (int a = 0; a < 2; ++a)
#pragma unroll
            for (int b = 0; b < 2; ++b)
#pragma unroll
                for (int m = 0; m < 4; ++m)
#pragma unroll
                    for (int n = 0; n < 2; ++n) acc[a][b][m][n] = (f32x4){0.f, 0.f, 0.f, 0.f};
        cur = nxt; cA = nA; cB = nB; ++ui;
        if (wr == 1) PG8_BAR;
    }
    PG8_WAIT_V(0);
    PG8_BAR;
#undef PG8_SA
#undef PG8_SB
#undef PG8_STAGE
#undef PG8_LDA
#undef PG8_LDB
#undef PG8_MMA
#undef PG8_WAIT_V
#undef PG8_WAIT_L
#undef PG8_SCHED
}


__device__ __forceinline__ void rs_fill(const float* ssq, int pm, LAS float* rsl, int tid) {
    asm volatile("s_waitcnt lgkmcnt(0)" ::: "memory"); __builtin_amdgcn_s_barrier(); asm volatile("" ::: "memory");
    if (tid < 256) rsl[tid] = row_rstd16(ssq, pm * 256 + tid);
    asm volatile("s_waitcnt lgkmcnt(0)" ::: "memory"); __builtin_amdgcn_s_barrier(); asm volatile("" ::: "memory");
}
template <class Sched> __device__ __forceinline__ void rs_prefill(const Sched& Sd, const float* ssq, LAS float* tab) {
    int tid_ = threadIdx.x; asm volatile("" : "+v"(tid_));
    Unit u;
    for (int i = 0; i < 8 && Sd.next(i, u); ++i) { if (tid_ < 256) tab[i * 256 + tid_] = row_rstd16(ssq, u.pm * 256 + tid_); }
    __syncthreads();
}
#define EPI_FENCE() asm volatile("" ::: "memory")
typedef f32x4 Acc[2][2][4][2];

struct EpiSwiGLU {
    static constexpr bool PERM = true;
    bf16* H; const float* ssq; LAS float* rsl;
    __device__ __forceinline__ void operator()(Acc& acc, const Unit& u, int wr, int wc, int fr, int fq) const {
        asm volatile("" : "+v"(fr), "+v"(fq));
        const int row0 = u.pm * BM + wr * 64 + fr, col0 = u.pn * 128 + wc * 32 + 8 * fq;
        const LAS float* rst = rsl + u.aux * 256;
#pragma unroll
        for (int ai = 0; ai < 2; ++ai)
#pragma unroll
            for (int m = 0; m < 4; ++m) { const int row = row0 + ai * HALF + m * 16; const float rs = rst[row & 255]; EPI_FENCE();
                float h[8];
#pragma unroll
                for (int n = 0; n < 2; ++n)
#pragma unroll
                    for (int j = 0; j < 4; ++j) { const float g = acc[ai][0][m][n][j] * rs, up = acc[ai][1][m][n][j] * rs; h[n * 4 + j] = siluf_(g) * up; }
                u32x4 w; w.x = pk2(h[0], h[1]); w.y = pk2(h[2], h[3]); w.z = pk2(h[4], h[5]); w.w = pk2(h[6], h[7]);
                *(u32x4*)(H + (size_t)row * FF + col0) = w; }
    }
};
struct EpiResid {
    static constexpr bool PERM = false;
    float* X; bf16* XB; float* ssq; float alpha; const float* Xr;
    __device__ __forceinline__ void operator()(Acc& acc, const Unit& u, int wr, int wc, int fr, int fq) const {
        asm volatile("" : "+v"(fr), "+v"(fq));
        const int row0 = u.pm * BM + wr * 64 + fr, col0 = u.pn * BM + wc * 32 + 4 * fq;
        const long dx = Xr - X;
        const unsigned off0 = (unsigned)row0 * D + col0;
#pragma unroll
        for (int ai = 0; ai < 2; ++ai)
#pragma unroll
            for (int mp = 0; mp < 2; ++mp) {
                f32x4 xv[2][4];
#pragma unroll
                for (int mm = 0; mm < 2; ++mm)
#pragma unroll
                    for (int bj = 0; bj < 2; ++bj)
#pragma unroll
                        for (int n = 0; n < 2; ++n) xv[mm][bj * 2 + n] = *(const f32x4*)(X + dx + (off0 + (unsigned)((ai * HALF + (mp * 2 + mm) * 16) * D + bj * HALF + n * 16)));
#pragma unroll
                for (int mm = 0; mm < 2; ++mm) { const int m = mp * 2 + mm; const int row = row0 + ai * HALF + m * 16; float sq = 0.f;
#pragma unroll
                    for (int bj = 0; bj < 2; ++bj)
#pragma unroll
                        for (int n = 0; n < 2; ++n) { const unsigned off = off0 + (unsigned)((ai * HALF + m * 16) * D + bj * HALF + n * 16);
                            const f32x4 v = xv[mm][bj * 2 + n] + acc[ai][bj][m][n] * alpha; *(f32x4*)(X + off) = v;
                            if (XB) { u32x2 w; w.x = pk2(v[0], v[1]); w.y = pk2(v[2], v[3]); *(u32x2*)(XB + off) = w; }
                            sq += (v[0] * v[0] + v[1] * v[1]) + (v[2] * v[2] + v[3] * v[3]); }
                    sq += __shfl_xor(sq, 16); sq += __shfl_xor(sq, 32);
                    if (fq == 0) ssq[(size_t)row * 16 + u.pn * 4 + wc] = sq; }
                EPI_FENCE(); }
    }
};
struct EpiBf16 {
    static constexpr bool PERM = true;
    bf16* O; int ldc; const float* rsp; int mode; float scale; LAS float* rsl;
    __device__ __forceinline__ void store(Acc& acc, bf16* base, int row0, int col0, int tabo = 0) const {
#pragma unroll
        for (int ai = 0; ai < 2; ++ai)
#pragma unroll
            for (int m = 0; m < 4; ++m) { const int row = row0 + ai * HALF + m * 16;
                float rs = scale; if (mode == 1) rs *= rsl[tabo + (row & 255)]; else if (mode == 2) rs *= rsp[row]; EPI_FENCE();
                bf16* rowp = base + (size_t)row * ldc + col0;
#pragma unroll
                for (int bj = 0; bj < 2; ++bj) { const f32x4 v0 = acc[ai][bj][m][0] * rs, v1 = acc[ai][bj][m][1] * rs;
                    u32x4 w; w.x = pk2(v0[0], v0[1]); w.y = pk2(v0[2], v0[3]); w.z = pk2(v1[0], v1[1]); w.w = pk2(v1[2], v1[3]);
                    *(u32x4*)(rowp + bj * HALF) = w; } }
    }
    __device__ __forceinline__ void operator()(Acc& acc, const Unit& u, int wr, int wc, int fr, int fq) const {
        asm volatile("" : "+v"(fr), "+v"(fq));
        store(acc, O, u.pm * BM + wr * 64 + fr, u.pn * BM + wc * 32 + 8 * fq, u.aux * 256);
    }
};
template <int kind> struct EpiPrep {
    static constexpr bool PERM = true;
    unsigned char* ws;
    __device__ __forceinline__ void operator()(Acc& acc, const Unit& u, int wr, int wc, int fr, int fq) const {
        asm volatile("" : "+v"(fr), "+v"(fq));
        EpiBf16 e; e.rsl = nullptr; const int r0 = wr * 64 + fr, c0 = wc * 32 + 8 * fq;
        if constexpr (kind == 0) { const int l = u.aux >> 3, t = u.aux & 7; e.O = (bf16*)(ws + WS_KV) + (size_t)l * 256 * 2048; e.ldc = 2048; e.rsp = (const float*)(ws + WS_MEMRS); e.mode = 2; e.scale = 1.f; e.store(acc, e.O, r0, t * 256 + c0); }
        else if constexpr (kind == 1) { const int l = u.aux >> 4, h = (u.aux >> 2) & 3, t = u.aux & 3; e.O = (bf16*)(ws + WS_WQK) + (size_t)l * 1024 * 1024; e.ldc = 1024; e.rsp = nullptr; e.mode = 0; e.scale = 1.f; e.store(acc, e.O, h * 256 + r0, t * 256 + c0); }
        else { const int l = u.aux >> 4, h = (u.aux >> 2) & 3, t = u.aux & 3; e.O = (bf16*)(ws + WS_WVO) + (size_t)l * 1024 * 1024; e.ldc = 1024; e.rsp = nullptr; e.mode = 0; e.scale = 1.f; e.store(acc, e.O, t * 256 + r0, h * 256 + c0); }
    }
};
struct EpiDN {
    static constexpr bool PERM = true;
    bf16* QKV; bf16* Z; bf16* HALO; float* AB; const float* ssq; const float* a_log; const float* dt_bias; LAS float* rsl;
    __device__ __forceinline__ void operator()(Acc& acc, const Unit& u, int wr, int wc, int fr, int fq) const {
        asm volatile("" : "+v"(fr), "+v"(fq));
        const int row0 = u.pm * BM + wr * 64 + fr, c0 = wc * 32 + 8 * fq;
        const LAS float* rst = rsl + u.aux * 256;
#pragma unroll
        for (int ai = 0; ai < 2; ++ai)
#pragma unroll
            for (int m = 0; m < 4; ++m) { const int row = row0 + ai * HALF + m * 16; const float rs = rst[row & 255]; EPI_FENCE();
                if (u.pn < 16) {
#pragma unroll
                    for (int bj = 0; bj < 2; ++bj) { const f32x4 v0 = acc[ai][bj][m][0] * rs, v1 = acc[ai][bj][m][1] * rs;
                        u32x4 w; w.x = pk2(v0[0], v0[1]); w.y = pk2(v0[2], v0[3]); w.z = pk2(v1[0], v1[1]); w.w = pk2(v1[2], v1[3]);
                        if (u.pn < 12) { const int col = u.pn * 256 + bj * HALF + c0; *(u32x4*)(QKV + (size_t)row * QKVW + col) = w;
                            if ((row & 63) >= 61) *(u32x4*)(HALO + ((size_t)(row >> 6) * 3 + ((row & 63) - 61)) * QKVW + col) = w; }
                        else { const int col = (u.pn - 12) * 256 + bj * HALF + c0; *(u32x4*)(Z + (size_t)row * D + col) = w; } }
                } else if (wc == 0 && fq < 2) {
#pragma unroll
                    for (int n = 0; n < 2; ++n) { f32x4 o;
#pragma unroll
                        for (int j = 0; j < 4; ++j) { const float v = acc[ai][0][m][n][j] * rs; const int h = 4 * n + j;
                            o[j] = (fq == 0) ? -__expf(a_log[h]) * softplusf_(v + dt_bias[h]) : sigmoidf_(v); }
                        *(f32x4*)(AB + (size_t)row * 16 + 8 * fq + 4 * n) = o; }
                } }
    }
};
struct EpiSoftmax {
    static constexpr bool PERM = true;
    bf16* P; const float* ssq; LAS float* red;
    __device__ __forceinline__ void operator()(Acc& acc, const Unit& u, int wr, int wc, int fr, int fq) const {
        asm volatile("" : "+v"(fr), "+v"(fq));
        const int rl0 = wr * 64 + fr, col0 = u.pn * BM + wc * 32 + 8 * fq;
        float mx[2][4];
        rs_fill(ssq, u.pm, red + 2048, (wr * 4 + wc) * 64 + fq * 16 + fr);
#pragma unroll
        for (int ai = 0; ai < 2; ++ai)
#pragma unroll
            for (int m = 0; m < 4; ++m) { const int rl = rl0 + ai * HALF + m * 16; const float rs = red[2048 + rl]; float t = -3.0e38f;
#pragma unroll
                for (int bj = 0; bj < 2; ++bj)
#pragma unroll
                    for (int n = 0; n < 2; ++n) { acc[ai][bj][m][n] = acc[ai][bj][m][n] * rs; const f32x4 v = acc[ai][bj][m][n]; t = fmaxf(t, fmaxf(fmaxf(v[0], v[1]), fmaxf(v[2], v[3]))); }
                t = fmaxf(t, __shfl_xor(t, 16)); t = fmaxf(t, __shfl_xor(t, 32));
                if (fq == 0) red[rl * 4 + wc] = t; }
        __syncthreads();
#pragma unroll
        for (int ai = 0; ai < 2; ++ai)
#pragma unroll
            for (int m = 0; m < 4; ++m) { const int rl = rl0 + ai * HALF + m * 16; const f32x4 r = *(const LAS f32x4*)(red + rl * 4);
                const float M = fmaxf(fmaxf(r[0], r[1]), fmaxf(r[2], r[3])); float s = 0.f;
#pragma unroll
                for (int bj = 0; bj < 2; ++bj)
#pragma unroll
                    for (int n = 0; n < 2; ++n) { f32x4 v = acc[ai][bj][m][n];
#pragma unroll
                        for (int j = 0; j < 4; ++j) { v[j] = __expf(v[j] - M); s += v[j]; }
                        acc[ai][bj][m][n] = v; }
                s += __shfl_xor(s, 16); s += __shfl_xor(s, 32);
                if (fq == 0) red[1024 + rl * 4 + wc] = s; mx[ai][m] = 0.f; }
        __syncthreads();
#pragma unroll
        for (int ai = 0; ai < 2; ++ai)
#pragma unroll
            for (int m = 0; m < 4; ++m) { const int rl = rl0 + ai * HALF + m * 16; const f32x4 r = *(const LAS f32x4*)(red + 1024 + rl * 4);
                const float inv = 1.f / ((r[0] + r[1]) + (r[2] + r[3]));
                bf16* rowp = P + (size_t)(u.pm * BM + rl) * D + col0;
#pragma unroll
                for (int bj = 0; bj < 2; ++bj) { const f32x4 v0 = acc[ai][bj][m][0] * inv, v1 = acc[ai][bj][m][1] * inv;
                    u32x4 w; w.x = pk2(v0[0], v0[1]); w.y = pk2(v0[2], v0[3]); w.z = pk2(v1[0], v1[1]); w.w = pk2(v1[2], v1[3]);
                    *(u32x4*)(rowp + bj * HALF) = w; } }
        __syncthreads();
        (void)mx;
    }
};
struct KvSched {
    int G, c; const unsigned char* ws;
    __device__ bool next(int i, Unit& u) const { const int L = i * G + c; if (L >= 16) return false; const int l = L >> 3, t = L & 7; u.pm = 0; u.pn = t; u.aux = L;
        u.a = (const char*)(ws + WS_MEMB); u.b = (const char*)(ws + WS_OB + (size_t)l * 8 * MiB) + (size_t)t * 256 * 1024 * 2; return true; }
};
struct QkSched {
    int G, c; const unsigned char* ws;
    __device__ bool next(int i, Unit& u) const { const int L = i * G + c; if (L >= 32) return false; const int l = L >> 4, h = (L >> 2) & 3, t = L & 3; u.pm = 0; u.pn = 0; u.aux = L;
        u.a = (const char*)(ws + WS_KV) + ((size_t)l * 256 * 2048 + h * 256) * 2;
        u.b = (const char*)(ws + WS_OB + (size_t)l * 8 * MiB + 4 * MiB) + ((size_t)t * 256 * 1024 + h * 256) * 2; return true; }
};
struct VoSched {
    int G, c; const unsigned char* ws;
    __device__ bool next(int i, Unit& u) const { const int L = i * G + c; if (L >= 32) return false; const int l = L >> 4, h = (L >> 2) & 3, t = L & 3; u.pm = 0; u.pn = 0; u.aux = L;
        u.a = (const char*)(ws + WS_OB + (size_t)l * 8 * MiB + 6 * MiB) + ((size_t)t * 256 * 1024 + h * 256) * 2;
        u.b = (const char*)(ws + WS_KV) + ((size_t)l * 256 * 2048 + 1024 + h * 256) * 2; return true; }
};
#undef PG8_BAR
}

__device__ __forceinline__ void transpose_item(const float* W, int K, int N, bf16* WT, const float* gk, int mode, LAS float* scr, int item, int lane) {
    const int nblk = (N + 31) / 32, kb = item / nblk, nb = item % nblk, k0 = 64 * kb, n0 = 32 * nb;
    const int kr = lane >> 3, c4 = (lane & 7) * 4; const bool ok = (n0 + c4) < N;
    f32x4 v[8];
#pragma unroll
    for (int i = 0; i < 8; ++i) v[i] = ok ? *(const f32x4*)(W + (size_t)(k0 + 8 * i + kr) * N + n0 + c4) : (f32x4){0.f, 0.f, 0.f, 0.f};
    if (gk) {
#pragma unroll
        for (int i = 0; i < 8; ++i) v[i] = v[i] * gk[k0 + 8 * i + kr]; }
#pragma unroll
    for (int i = 0; i < 8; ++i) { LAS float* d = scr + (8 * i + kr) * 33 + c4; d[0] = v[i][0]; d[1] = v[i][1]; d[2] = v[i][2]; d[3] = v[i][3]; }
    asm volatile("s_waitcnt lgkmcnt(0)" ::: "memory");
    const int c = lane & 7;
#pragma unroll
    for (int j = 0; j < 4; ++j) { const int n = (lane >> 3) + 8 * j; const LAS float* s = scr + (8 * c) * 33 + n;
        u32x4 o; o.x = pk2(s[0 * 33], s[1 * 33]); o.y = pk2(s[2 * 33], s[3 * 33]); o.z = pk2(s[4 * 33], s[5 * 33]); o.w = pk2(s[6 * 33], s[7 * 33]);
        int nr = n0 + n;
        if (mode == 1) { nr = nr < FF ? ((nr >> 7) * 256 + (nr & 127)) : (((nr - FF) >> 7) * 256 + 128 + ((nr - FF) & 127)); }
        *(u32x4*)(WT + (size_t)nr * K + k0 + 8 * c) = o; }
    asm volatile("s_waitcnt lgkmcnt(0)" ::: "memory");
}
__device__ __forceinline__ float wave_sum(float v) {
#pragma unroll
    for (int o = 1; o < 64; o <<= 1) v += __shfl_xor(v, o);
    return v;
}

struct Args { const float* in[30]; float* out; unsigned char* ws; };
__device__ __forceinline__ const void* karg(int i) {
    const __attribute__((address_space(4))) char* k = (const __attribute__((address_space(4))) char*)__builtin_amdgcn_kernarg_segment_ptr();
    asm volatile("" : "+s"(k));
    return *(const void* const __attribute__((address_space(4)))*)(k + 8 * i);
}
#define argin(i) ((const float*)karg(i))
#define argout() ((float*)karg(30))
#define argws() ((unsigned char*)karg(31))


#define TJ_RUN(W_, K_, N_, WT_, gk_, mode_) do { const int n_ = ((K_) / 64) * (((N_) + 31) / 32); for (int it = gw; it < n_; it += NGW) transpose_item((W_), (K_), (N_), (WT_), (gk_), (mode_), scr, it, lane); } while (0)
__device__ __forceinline__ void layer_weights(int l, int part, int gw, int NGW, LAS float* scr, int lane) {
    unsigned char* ws = argws();
    if (part & 2) {
        TJ_RUN(argin(12) + (size_t)l * D * 2 * FF, D, 2 * FF, (bf16*)(ws + WS_F2IN), argin(11) + l * D, 1);
        TJ_RUN(argin(13) + (size_t)l * FF * D, FF, D, (bf16*)(ws + WS_F2OUT), (const float*)nullptr, 0); }
    if (part & 1) {
        TJ_RUN(argin(3) + (size_t)l * D * 2 * FF, D, 2 * FF, (bf16*)(ws + WS_F1IN), argin(2) + l * D, 1);
        TJ_RUN(argin(4) + (size_t)l * FF * D, FF, D, (bf16*)(ws + WS_F1OUT), (const float*)nullptr, 0); }
    if (part & 4) {
        if (l == 0) { TJ_RUN(argin(14), D, ABN, (bf16*)(ws + WS_MIXIN), argin(5), 0); TJ_RUN(argin(22), D, D, (bf16*)(ws + WS_MIXOUT), (const float*)nullptr, 0); }
        else { TJ_RUN(argin(23), D, DNREAL, (bf16*)(ws + WS_MIXIN), argin(5) + D, 0); TJ_RUN(argin(28), D, D, (bf16*)(ws + WS_MIXOUT), (const float*)nullptr, 0); } }
}

struct AtRegs { bf16x8 k00, k01, k10, k11; u32x4 vv[4]; };
struct AtState { int t0; const bf16* kbase; const bf16* vbase; bf16x8 qf0, qf1; float mrun, lrun; f32x4 o[4]; LAS unsigned char* vt; };
__device__ __forceinline__ void attn_init(AtState& U, const bf16* __restrict__ QKV, LAS unsigned char* vt, int u, int lane) {
    const int r16 = u & 15, h = (u >> 4) & 7, blk = u >> 7, c = lane & 15, q = lane >> 4, hf = lane >> 5;
    U.t0 = blk * 256 + r16; U.vt = vt;
    const bf16* qrow = QKV + (size_t)(U.t0 + 16 * c) * ABN + h * 64;
    U.qf0 = *(const bf16x8*)(qrow + 8 * q); U.qf1 = *(const bf16x8*)(qrow + 32 + 8 * q);
    U.mrun = -1.0e30f; U.lrun = 0.f;
#pragma unroll
    for (int i = 0; i < 4; ++i) U.o[i] = (f32x4){0.f, 0.f, 0.f, 0.f};
    U.kbase = QKV + 512 + h * 64 + 8 * q; U.vbase = QKV + 1024 + h * 64 + (lane & 3) * 8; (void)hf;
}
__device__ __forceinline__ void attn_load(const AtState& U, AtRegs& R, const int n, int lane) {
    const int c = lane & 15, kk = lane & 31;
    const int di = n < 12 ? 0 : (n < 18 ? 1 : 2), T = n - (di == 0 ? 0 : (di == 1 ? 12 : 18));
    const int d = 1 << (2 * di), kstart = U.t0 - 128 * d;
    int tk0 = kstart + (32 * T + c) * d; tk0 = tk0 < 0 ? 0 : (tk0 > S - 1 ? S - 1 : tk0);
    int tk1 = kstart + (32 * T + 16 + c) * d; tk1 = tk1 < 0 ? 0 : (tk1 > S - 1 ? S - 1 : tk1);
    int tv0 = kstart + (32 * T + (lane >> 2)) * d; tv0 = tv0 < 0 ? 0 : (tv0 > S - 1 ? S - 1 : tv0);
    int tv1 = kstart + (32 * T + 16 + (lane >> 2)) * d; tv1 = tv1 < 0 ? 0 : (tv1 > S - 1 ? S - 1 : tv1);
    const bf16* k0p = U.kbase + (size_t)tk0 * ABN; const bf16* k1p = U.kbase + (size_t)tk1 * ABN;
    R.k00 = *(const bf16x8*)k0p; R.k01 = *(const bf16x8*)(k0p + 32); R.k10 = *(const bf16x8*)k1p; R.k11 = *(const bf16x8*)(k1p + 32);
    const bf16* v0p = U.vbase + (size_t)tv0 * ABN; const bf16* v1p = U.vbase + (size_t)tv1 * ABN;
    R.vv[0] = *(const u32x4*)v0p; R.vv[1] = *(const u32x4*)v1p; R.vv[2] = *(const u32x4*)(v0p + 32); R.vv[3] = *(const u32x4*)(v1p + 32);
    (void)kk;
}
__device__ __forceinline__ void attn_compute(AtState& U, const AtRegs& R, const int n, int lane) {
    const int c = lane & 15, q = lane >> 4, kk = lane & 31, hf = lane >> 5;
    const float SC = 0.125f * 1.4426950408889634f;
    const int di = n < 12 ? 0 : (n < 18 ? 1 : 2), T = n - (di == 0 ? 0 : (di == 1 ? 12 : 18));
    const int d = 1 << (2 * di), e = 16 >> (2 * di), kstart = U.t0 - 128 * d;
    const int lo = c * e, hi = c * e + 128;
    f32x4 s0 = (f32x4){0.f, 0.f, 0.f, 0.f}, s1 = s0;
    s0 = MFMA16(R.k00, U.qf0, s0); s0 = MFMA16(R.k01, U.qf1, s0);
    s1 = MFMA16(R.k10, U.qf0, s1); s1 = MFMA16(R.k11, U.qf1, s1);
    bool v0[4], v1[4]; float tmax = -1.0e30f;
#pragma unroll
    for (int i = 0; i < 4; ++i) { const int n0 = 32 * T + 4 * q + i, n1 = n0 + 16;
        v0[i] = (n0 >= lo) && (n0 <= hi) && (kstart + n0 * d >= 0); v1[i] = (n1 >= lo) && (n1 <= hi) && (kstart + n1 * d >= 0);
        s0[i] = v0[i] ? s0[i] * SC : -1.0e30f; s1[i] = v1[i] ? s1[i] * SC : -1.0e30f;
        tmax = fmaxf(tmax, fmaxf(s0[i], s1[i])); }
    tmax = qred_max(tmax);
    const float mnew = fmaxf(U.mrun, tmax), alpha = __builtin_amdgcn_exp2f(U.mrun - mnew);
    float ps = 0.f; f32x4 p0, p1;
#pragma unroll
    for (int i = 0; i < 4; ++i) { p0[i] = v0[i] ? __builtin_amdgcn_exp2f(s0[i] - mnew) : 0.f; p1[i] = v1[i] ? __builtin_amdgcn_exp2f(s1[i] - mnew) : 0.f; ps += p0[i] + p1[i]; }
    ps = qred_sum(ps);
    U.lrun = U.lrun * alpha + ps; U.mrun = mnew;
#pragma unroll
    for (int i = 0; i < 4; ++i) U.o[i] = U.o[i] * alpha;
    const bf16x8 pb = pack8(p0, p1);
    LAS unsigned char* vt = U.vt;
#pragma unroll
    for (int i = 0; i < 4; ++i) *(LAS u32x4*)(vt + ((lane >> 2) + 16 * (i & 1)) * 144 + 64 * (i >> 1) + 16 * (lane & 3)) = R.vv[i];
    (void)kk; (void)hf;
    __builtin_amdgcn_wave_barrier(); asm volatile("s_waitcnt lgkmcnt(0)" ::: "memory");
    { const int rq = (lane & 15) >> 2, p4 = lane & 3; LAS unsigned char* tb = vt + (4 * q + rq) * 144 + p4 * 8;
#pragma unroll
      for (int Dt = 0; Dt < 4; ++Dt) {
          const s16x4 lo8 = __builtin_amdgcn_ds_read_tr16_b64_v4i16((LAS s16x4*)(tb + Dt * 32));
          const s16x4 hi8 = __builtin_amdgcn_ds_read_tr16_b64_v4i16((LAS s16x4*)(tb + 16 * 144 + Dt * 32));
          const bf16x8 vf = __builtin_shufflevector(lo8, hi8, 0, 1, 2, 3, 4, 5, 6, 7);
          U.o[Dt] = MFMA16(vf, pb, U.o[Dt]); } }
    __builtin_amdgcn_wave_barrier();
}
__device__ __forceinline__ void attn_finish(const AtState& U, bf16* __restrict__ OB, int u, int lane) {
    const int h = (u >> 4) & 7, c = lane & 15, q = lane >> 4;
    const float inv = 1.f / U.lrun;
    bf16* orow = OB + (size_t)(U.t0 + 16 * c) * D + h * 64 + 4 * q;
#pragma unroll
    for (int Dt = 0; Dt < 4; ++Dt) { u32x2 w; w.x = pk2(U.o[Dt][0] * inv, U.o[Dt][1] * inv); w.y = pk2(U.o[Dt][2] * inv, U.o[Dt][3] * inv); *(u32x2*)(orow + 16 * Dt) = w; }
}
__device__ __forceinline__ void attn_unit2(const bf16* __restrict__ QKV, bf16* __restrict__ OB, LAS unsigned char* vt, int ua, int ub, int lane) {
    AtState A, B; AtRegs RA, RB;
    attn_init(A, QKV, vt, ua, lane); attn_init(B, QKV, vt + 4608, ub, lane);
    attn_load(A, RA, 0, lane); attn_load(B, RB, 0, lane);
    for (int n = 0; n < 23; ++n) { const int nn = n + 1 < 23 ? n + 1 : 22;
        attn_compute(A, RA, n, lane); attn_load(A, RA, nn, lane);
        attn_compute(B, RB, n, lane); attn_load(B, RB, nn, lane); }
    attn_finish(A, OB, ua, lane); attn_finish(B, OB, ub, lane);
}

__device__ __forceinline__ void lru_local_unit(LAS float* L, int unit, const bool load_w) {
    int tid_l = threadIdx.x; asm volatile("" : "+v"(tid_l));
    const int tt = unit >> 3, cb = unit & 7, tid = tid_l, k = tid & 63, tg = tid >> 6;
    const bf16* XG = (const bf16*)(argws() + WS_BIG);
    LAS float* xc = L; LAS float* wa = L + 64 * 65; LAS float* wx = wa + 4096; LAS float* LA = wx + 4096; LAS float* LB = LA + 64 * 65;
    const float* Wa = argin(17) + (size_t)cb * 4096; const float* Wx = argin(19) + (size_t)cb * 4096;
    if (load_w) { for (int i = tid; i < 4096; i += 512) { wa[i] = Wa[i]; wx[i] = Wx[i]; } }
    const int ch = cb * 64 + k;
    { const float cw0 = argin(15)[ch], cw1 = argin(15)[512 + ch], cw2 = argin(15)[1024 + ch], cw3 = argin(15)[1536 + ch], cbias = argin(16)[ch];
      const int tb = tt * 64 + tg * 8;
      float xm3 = tb - 3 >= 0 ? bf2f(XG[(size_t)(tb - 3) * ABN + 1536 + ch]) : 0.f, xm2 = tb - 2 >= 0 ? bf2f(XG[(size_t)(tb - 2) * ABN + 1536 + ch]) : 0.f, xm1 = tb - 1 >= 0 ? bf2f(XG[(size_t)(tb - 1) * ABN + 1536 + ch]) : 0.f;
#pragma unroll
      for (int i = 0; i < 8; ++i) { const float x0 = bf2f(XG[(size_t)(tb + i) * ABN + 1536 + ch]);
          xc[(tg * 8 + i) * 65 + k] = cbias + cw0 * xm3 + cw1 * xm2 + cw2 * xm1 + cw3 * x0; xm3 = xm2; xm2 = xm1; xm1 = x0; } }
    __syncthreads();
    float ra[8], ri[8];
#pragma unroll
    for (int i = 0; i < 8; ++i) { ra[i] = 0.f; ri[i] = 0.f; }
    for (int j = 0; j < 64; ++j) { const float aw = wa[j * 64 + k], xw = wx[j * 64 + k];
#pragma unroll
        for (int i = 0; i < 8; ++i) { const float xv = xc[(tg * 8 + i) * 65 + j]; ra[i] += xv * aw; ri[i] += xv * xw; } }
    float hl[8], pl[8];
    { const float ba = argin(18)[ch], bx = argin(20)[ch], spl = softplusf_(-argin(21)[ch]); float hh = 0.f, pp = 1.f;
#pragma unroll
      for (int i = 0; i < 8; ++i) { const float r = sigmoidf_(ra[i] + ba), ig = sigmoidf_(ri[i] + bx);
          const float log_a = -8.0f * r * spl; const float av = __expf(log_a); const float mult = sqrtf(-expm1f(2.f * log_a));
          const float bv = mult * ig * xc[(tg * 8 + i) * 65 + k];
          hh = av * hh + bv; pp *= av; hl[i] = hh; pl[i] = pp; }
      LA[tg * 64 + k] = pp; LB[tg * 64 + k] = hh; }
    __syncthreads();
    { float Hc = 0.f, Pc = 1.f;
#pragma unroll
      for (int g = 0; g < 7; ++g) if (g < tg) { const float pg = LA[g * 64 + k], hg = LB[g * 64 + k]; Hc = pg * Hc + hg; Pc *= pg; }
      float* HL = (float*)(argws() + WS_XB); float* PC = (float*)(argws() + WS_BIG + 80 * MiB);
#pragma unroll
      for (int i = 0; i < 8; ++i) { const size_t off = (size_t)(tt * 64 + tg * 8 + i) * 512 + ch; HL[off] = hl[i] + pl[i] * Hc; PC[off] = pl[i] * Pc; }
      if (tg == 7) { float* TOT = (float*)(argws() + WS_LRUTOT); TOT[(size_t)tt * 512 + ch] = pl[7] * Pc; TOT[(size_t)(256 + tt) * 512 + ch] = hl[7] + pl[7] * Hc; } }
    __syncthreads();
}
__device__ __forceinline__ void lru_apply_wg(LAS float* L, int bx, int G) {
    int tid_l = threadIdx.x; asm volatile("" : "+v"(tid_l));
    const int tid = tid_l, k = tid & 63, tg = tid >> 6, cb = bx & 7, ch = cb * 64 + k;
    unsigned char* ws = argws();
    const float* TOT = (const float*)(ws + WS_LRUTOT);
    const float* HL = (const float*)(ws + WS_XB); const float* PC = (const float*)(ws + WS_BIG + 80 * MiB);
    const bf16* XG = (const bf16*)(ws + WS_BIG); bf16* OB = (bf16*)(ws + WS_OB);
    float H = 0.f; int cprev = 0;
    for (int tt = bx >> 3; tt < 256; tt += (G >> 3)) {
        if (tid < 64) {
            int c = cprev;
            for (; c + 32 <= tt; c += 32) { float av[32], bv[32];
#pragma unroll
                for (int i = 0; i < 32; ++i) { av[i] = TOT[(size_t)(c + i) * 512 + ch]; bv[i] = TOT[(size_t)(256 + c + i) * 512 + ch]; }
#pragma unroll
                for (int i = 0; i < 32; ++i) H = av[i] * H + bv[i]; }
            for (; c + 8 <= tt; c += 8) { float av[8], bv[8];
#pragma unroll
                for (int i = 0; i < 8; ++i) { av[i] = TOT[(size_t)(c + i) * 512 + ch]; bv[i] = TOT[(size_t)(256 + c + i) * 512 + ch]; }
#pragma unroll
                for (int i = 0; i < 8; ++i) H = av[i] * H + bv[i]; }
            for (; c < tt; ++c) H = TOT[(size_t)c * 512 + ch] * H + TOT[(size_t)(256 + c) * 512 + ch];
            L[tid] = H; }
        cprev = tt;
        __syncthreads();
        const float Hin = L[k];
#pragma unroll
        for (int i = 0; i < 8; ++i) { const int t = tt * 64 + tg * 8 + i; const size_t off = (size_t)t * 512 + ch;
            const float hv = HL[off] + PC[off] * Hin; const float gr = bf2f(XG[(size_t)t * ABN + 2048 + ch]);
            OB[(size_t)t * D + 512 + ch] = (unsigned short)(pk2(hv * gelu_tanh(gr), 0.f) & 0xffffu); }
        __syncthreads();
    }
}

__device__ __forceinline__ void dn_local_unit(LAS unsigned char* lds, int unit) {
    int tid_l = threadIdx.x; asm volatile("" : "+v"(tid_l));
    const int c = unit >> 3, h = unit & 7, tid = tid_l, lane = tid & 63, wid = tid >> 6;
    bf16* QKV = (bf16*)(argws() + WS_BIG); const bf16* HALO = (const bf16*)(argws() + WS_HALO);
    const float* AB = (const float*)(argws() + WS_DNAB);
    LAS unsigned char* qb = lds; LAS unsigned char* kb = lds + 17408; LAS unsigned char* vb = lds + 34816;
    LAS float* Am = (LAS float*)(lds + 52224);
    LAS float* sc = (LAS float*)(lds + 52224 + 16384);
    { const int i = tid >> 3, sg = tid & 7;
#pragma unroll
      for (int ten = 0; ten < 3; ++ten) { const int col = ten * 1024 + h * 128 + sg * 8;
          float val[16];
#pragma unroll
          for (int e = 0; e < 16; ++e) val[e] = 0.f;
#pragma unroll
          for (int j = 0; j < 4; ++j) { const int ri = i + j - 3; const bf16* src;
              bool zero = false;
              if (ri >= 0) src = QKV + (size_t)(c * 64 + ri) * QKVW + col; else if (c > 0) src = HALO + ((size_t)(c - 1) * 3 + (ri + 3)) * QKVW + col; else { zero = true; src = QKV; }
              u32x4 r0 = (u32x4){0u, 0u, 0u, 0u}, r1 = r0; if (!zero) { r0 = *(const u32x4*)src; r1 = *(const u32x4*)(src + 64); }
              const float* cw = argin(24) + (size_t)j * QKVW + col;
              const f32x4 w0 = *(const f32x4*)cw, w1 = *(const f32x4*)(cw + 4), w2 = *(const f32x4*)(cw + 64), w3 = *(const f32x4*)(cw + 68);
#pragma unroll
              for (int e = 0; e < 4; ++e) { val[2 * e] += bflo(r0[e]) * (e < 2 ? w0[2 * e] : w1[2 * e - 4]); val[2 * e + 1] += bfhi(r0[e]) * (e < 2 ? w0[2 * e + 1] : w1[2 * e - 3]);
                  val[8 + 2 * e] += bflo(r1[e]) * (e < 2 ? w2[2 * e] : w3[2 * e - 4]); val[8 + 2 * e + 1] += bfhi(r1[e]) * (e < 2 ? w2[2 * e + 1] : w3[2 * e - 3]); } }
          float ss = 0.f;
#pragma unroll
          for (int e = 0; e < 16; ++e) { val[e] = siluf_(val[e]); ss += val[e] * val[e]; }
          float scl = 1.f;
          if (ten < 2) { ss += __shfl_xor(ss, 1); ss += __shfl_xor(ss, 2); ss += __shfl_xor(ss, 4); scl = rsqrtf(ss + 1e-6f); }
          u32x4 o0, o1;
#pragma unroll
          for (int e = 0; e < 4; ++e) { o0[e] = pk2(val[2 * e] * scl, val[2 * e + 1] * scl); o1[e] = pk2(val[8 + 2 * e] * scl, val[8 + 2 * e + 1] * scl); }
          LAS unsigned char* dst = (ten == 0 ? qb : (ten == 1 ? kb : vb)) + i * 272 + sg * 16;
          *(LAS u32x4*)dst = o0; *(LAS u32x4*)(dst + 128) = o1; } }
    if (wid == 0) { const int t = c * 64 + lane; float g = AB[(size_t)t * 16 + h]; const float be = AB[(size_t)t * 16 + 8 + h];
#pragma unroll
        for (int o = 1; o < 64; o <<= 1) { const float y = __shfl_up(g, o); if (lane >= o) g += y; }
        sc[lane] = g; sc[64 + lane] = be; sc[128 + lane] = __expf(g);
        if (lane == 63) ((float*)(argws() + WS_DECAY))[c * 8 + h] = __expf(g); }
    __syncthreads();
    { const int cc = lane & 15, q = lane >> 4, rt = wid & 3; const bool isqk = wid >= 4;
      const LAS unsigned char* Ab = (isqk ? qb : kb) + (rt * 16 + cc) * 272 + 16 * q;
      bf16x8 af[4];
#pragma unroll
      for (int ks = 0; ks < 4; ++ks) af[ks] = *(const LAS bf16x8*)(Ab + 64 * ks);
#pragma unroll
      for (int ct = 0; ct < 4; ++ct) { f32x4 r = (f32x4){0.f, 0.f, 0.f, 0.f};
          const LAS unsigned char* Bb = kb + (ct * 16 + cc) * 272 + 16 * q;
#pragma unroll
          for (int ks = 0; ks < 4; ++ks) r = MFMA16(af[ks], *(const LAS bf16x8*)(Bb + 64 * ks), r);
          const int j = ct * 16 + cc; const float gj = sc[j];
#pragma unroll
          for (int e = 0; e < 4; ++e) { const int i = rt * 16 + 4 * q + e; const float gi = sc[i];
              if (!isqk) { Am[i * 64 + j] = (i > j) ? r[e] * sc[64 + i] * __expf(gi - gj) : 0.f; }
              else { const float v = (i >= j) ? r[e] * 0.08838834764831845f * __expf(gi - gj) : 0.f;
                  ((bf16*)(argws() + WS_OB))[((size_t)(c * 8 + h) * 64 + i) * 64 + j] = (unsigned short)(pk2(v, 0.f) & 0xffffu); } } } }
    __syncthreads();
    if (tid < 256) { const int cl = tid; float s[64];
        if (cl < 128) {
#pragma unroll
            for (int i = 0; i < 64; ++i) s[i] = bf2f(*(const LAS unsigned short*)(vb + i * 272 + cl * 2)) * sc[64 + i];
        } else {
#pragma unroll
            for (int i = 0; i < 64; ++i) s[i] = bf2f(*(const LAS unsigned short*)(kb + i * 272 + (cl - 128) * 2)) * sc[64 + i] * sc[128 + i];
        }
#pragma unroll
        for (int i = 1; i < 64; ++i) { float a4[4] = {0.f, 0.f, 0.f, 0.f};
#pragma unroll
            for (int j4 = 0; j4 < (i + 3) / 4; ++j4) { const f32x4 av = *(const LAS f32x4*)(Am + i * 64 + 4 * j4);
#pragma unroll
                for (int e = 0; e < 4; ++e) if (4 * j4 + e < i) a4[e] += av[e] * s[4 * j4 + e]; }
            s[i] = s[i] - ((a4[0] + a4[1]) + (a4[2] + a4[3])); }
        if (cl < 128) { bf16* dst = QKV + (size_t)(c * 64) * QKVW + 2048 + h * 128 + cl;
#pragma unroll
            for (int i = 0; i < 64; ++i) dst[(size_t)i * QKVW] = (unsigned short)(pk2(s[i], 0.f) & 0xffffu); }
        else { bf16* dst = (bf16*)(argws() + WS_XB) + (size_t)(c * 64) * D + h * 128 + (cl - 128);
#pragma unroll
            for (int i = 0; i < 64; ++i) dst[(size_t)i * D] = (unsigned short)(pk2(s[i], 0.f) & 0xffffu); }
    } else { const int t2 = tid - 256; const float glast = sc[63];
        { const int i = t2 >> 2, sg = t2 & 3; const float f = sc[128 + i] * 0.08838834764831845f;
          const LAS u32x4* src = (const LAS u32x4*)(qb + i * 272 + sg * 64); u32x4* dst = (u32x4*)(QKV + (size_t)(c * 64 + i) * QKVW + h * 128 + sg * 32);
#pragma unroll
          for (int p = 0; p < 4; ++p) { const u32x4 v = src[p]; u32x4 o;
#pragma unroll
              for (int e = 0; e < 4; ++e) o[e] = pk2(bflo(v[e]) * f, bfhi(v[e]) * f);
              dst[p] = o; } }
        { const int rr = t2 >> 1, hfj = t2 & 1;
          bf16* dst = QKV + (size_t)(c * 64 + (rr >> 1)) * QKVW + 1024 + h * 128 + (rr & 1) * 64 + hfj * 32;
#pragma unroll
          for (int p = 0; p < 4; ++p) { u32x4 o;
#pragma unroll
              for (int e = 0; e < 4; ++e) { const int j0 = hfj * 32 + p * 8 + 2 * e;
                  const float k0 = bf2f(*(const LAS unsigned short*)(kb + j0 * 272 + rr * 2)) * __expf(glast - sc[j0]);
                  const float k1 = bf2f(*(const LAS unsigned short*)(kb + (j0 + 1) * 272 + rr * 2)) * __expf(glast - sc[j0 + 1]);
                  o[e] = pk2(k0, k1); }
              *(u32x4*)(dst + p * 8) = o; } } }
    __syncthreads();
}

constexpr int DS_W = 0, DS_QG = 17408, DS_KD = 34816, DS_QK = 53248, DS_U = 62464, DS_BUF = 64512, DS_VN = 2 * DS_BUF, DS_ST = DS_VN + 2304;
__device__ __forceinline__ void dn_scan_worker(LAS unsigned char* lds, int worker, const int c0, const int c1, f32x4 (&Sacc)[2]) {
    int tid_l = threadIdx.x; asm volatile("" : "+v"(tid_l));
    const int h = worker >> 3, sl = worker & 7, tid = tid_l, lane = tid & 63, wid = __builtin_amdgcn_readfirstlane(tid >> 6);
    unsigned char* ws = argws();
    bf16* QKV = (bf16*)(ws + WS_BIG); const bf16* Wr = (const bf16*)(ws + WS_XB); const bf16* QKr = (const bf16*)(ws + WS_OB);
    const float* DEC = (const float*)(ws + WS_DECAY);
    const char* srcp[8]; unsigned strd[8], dsto[8]; u32x4 preA[8], preB[8];
#pragma unroll
    for (int i = 0; i < 8; ++i) { const int p = tid + 512 * i;
        if (p < 1024) { const int row = p >> 4, chn = p & 15; dsto[i] = DS_W + row * 272 + chn * 16; srcp[i] = (const char*)(Wr + (size_t)row * D + h * 128) + chn * 16; strd[i] = 64 * D * 2; }
        else if (p < 2048) { const int pp = p - 1024, row = pp >> 4, chn = pp & 15; dsto[i] = DS_QG + row * 272 + chn * 16; srcp[i] = (const char*)(QKV + (size_t)row * QKVW + h * 128) + chn * 16; strd[i] = 64 * QKVW * 2; }
        else if (p < 3072) { const int pp = p - 2048, seg = pp >> 4, chn = pp & 15; dsto[i] = DS_KD + (2 * seg + (chn >> 3)) * 144 + (chn & 7) * 16; srcp[i] = (const char*)(QKV + (size_t)seg * QKVW + 1024 + h * 128) + chn * 16; strd[i] = 64 * QKVW * 2; }
        else if (p < 3584) { const int pp = p - 3072, row = pp >> 3, chn = pp & 7; dsto[i] = DS_QK + row * 144 + chn * 16; srcp[i] = (const char*)(QKr + ((size_t)h * 64 + row) * 64) + chn * 16; strd[i] = 8 * 4096 * 2; }
        else { const int pp = (p - 3584) & 127, row = pp >> 1, chn = pp & 1; dsto[i] = DS_U + row * 32 + chn * 16; srcp[i] = (const char*)(QKV + (size_t)row * QKVW + 2048 + h * 128 + sl * 16) + chn * 16; strd[i] = 64 * QKVW * 2; } }
    const bool last_ok = tid < 128;
#define DN_LOAD(P, c) do { _Pragma("unroll") for (int i_ = 0; i_ < 8; ++i_) P[i_] = *(const u32x4*)(srcp[i_] + (size_t)(c) * strd[i_]); } while (0)
#define DN_STORE(P, bufo) do { _Pragma("unroll") for (int i_ = 0; i_ < 8; ++i_) if (i_ < 7 || last_ok) *(LAS u32x4*)(lds + (bufo) + dsto[i_]) = P[i_]; } while (0)
    DN_LOAD(preA, c0); DN_STORE(preA, 0); DN_LOAD(preA, c0 + 1); DN_LOAD(preB, c0 + 2);
    if (c0 == 0) { for (int i = tid; i < 4352 / 4; i += 512) ((LAS unsigned*)(lds + DS_ST))[i] = 0u; }
    if (tid < c1 - c0) ((LAS float*)(lds + DS_ST + 4352))[c0 + tid] = DEC[(c0 + tid) * 8 + h];
    __syncthreads();
    const int cc = lane & 15, q = lane >> 4, T = wid;
    auto step = [&](const int c, u32x4 (&P)[8]) {
        const int bo = (c & 1) * DS_BUF;
        DN_STORE(P, ((c + 1) & 1) * DS_BUF);
        DN_LOAD(P, c + 3 < c1 ? c + 3 : c1 - 1);
        const LAS unsigned char* B = lds + bo;
        f32x4 oa = (f32x4){0.f, 0.f, 0.f, 0.f};
        if (wid < 4) {
            f32x4 wS = (f32x4){0.f, 0.f, 0.f, 0.f};
#pragma unroll
            for (int ks = 0; ks < 4; ++ks) {
                const LAS unsigned char* sp = lds + DS_ST + cc * 272 + (32 * ks + 4 * q) * 2;
                const bf16x8 Sb = __builtin_shufflevector(*(const LAS s16x4*)sp, *(const LAS s16x4*)(sp + 32), 0, 1, 2, 3, 4, 5, 6, 7);
                const LAS unsigned char* wp = B + DS_W + (16 * T + cc) * 272 + (32 * ks + 4 * q) * 2;
                const bf16x8 wf = __builtin_shufflevector(*(const LAS s16x4*)wp, *(const LAS s16x4*)(wp + 32), 0, 1, 2, 3, 4, 5, 6, 7);
                wS = MFMA16(wf, Sb, wS);
                const LAS unsigned char* qp = B + DS_QG + (16 * T + cc) * 272 + (32 * ks + 4 * q) * 2;
                const bf16x8 qf = __builtin_shufflevector(*(const LAS s16x4*)qp, *(const LAS s16x4*)(qp + 32), 0, 1, 2, 3, 4, 5, 6, 7);
                oa = MFMA16(qf, Sb, oa); }
            f32x4 vn;
#pragma unroll
            for (int e = 0; e < 4; ++e) { const int row = 16 * T + 4 * q + e; vn[e] = bf2f(*(const LAS unsigned short*)(B + DS_U + row * 32 + cc * 2)) - wS[e]; }
            u32x2 w; w.x = pk2(vn[0], vn[1]); w.y = pk2(vn[2], vn[3]);
            *(LAS u32x2*)(lds + DS_VN + cc * 144 + (16 * T + 4 * q) * 2) = w;
        }
        asm volatile("s_waitcnt lgkmcnt(0)" ::: "memory"); __builtin_amdgcn_s_barrier(); asm volatile("" ::: "memory");
        if (wid < 4) {
            bf16x8 vbf[2];
#pragma unroll
            for (int k2 = 0; k2 < 2; ++k2) { const LAS unsigned char* vp = lds + DS_VN + cc * 144 + (32 * k2 + 4 * q) * 2;
                vbf[k2] = __builtin_shufflevector(*(const LAS s16x4*)vp, *(const LAS s16x4*)(vp + 32), 0, 1, 2, 3, 4, 5, 6, 7); }
#pragma unroll
            for (int k2 = 0; k2 < 2; ++k2) { const LAS unsigned char* pp = B + DS_QK + (16 * T + cc) * 144 + (32 * k2 + 4 * q) * 2;
                const bf16x8 pf = __builtin_shufflevector(*(const LAS s16x4*)pp, *(const LAS s16x4*)(pp + 32), 0, 1, 2, 3, 4, 5, 6, 7);
                oa = MFMA16(pf, vbf[k2], oa); }
            bf16* orow = QKV + (size_t)(c * 64) * QKVW + 2048 + h * 128 + sl * 16 + cc;
#pragma unroll
            for (int e = 0; e < 4; ++e) orow[(size_t)(16 * T + 4 * q + e) * QKVW] = (unsigned short)(pk2(oa[e], 0.f) & 0xffffu);
            const float dl = ((const LAS float*)(lds + DS_ST + 4352))[c];
#pragma unroll
            for (int r = 0; r < 2; ++r) { const int R = 2 * T + r; Sacc[r] = Sacc[r] * dl;
#pragma unroll
                for (int k2 = 0; k2 < 2; ++k2) { const LAS unsigned char* kp = B + DS_KD + (16 * R + cc) * 144 + (32 * k2 + 4 * q) * 2;
                    const bf16x8 kf = __builtin_shufflevector(*(const LAS s16x4*)kp, *(const LAS s16x4*)(kp + 32), 0, 1, 2, 3, 4, 5, 6, 7);
                    Sacc[r] = MFMA16(kf, vbf[k2], Sacc[r]); }
                u32x2 w; w.x = pk2(Sacc[r][0], Sacc[r][1]); w.y = pk2(Sacc[r][2], Sacc[r][3]);
                *(LAS u32x2*)(lds + DS_ST + cc * 272 + (16 * R + 4 * q) * 2) = w; }
        }
        asm volatile("s_waitcnt lgkmcnt(0)" ::: "memory"); __builtin_amdgcn_s_barrier(); asm volatile("" ::: "memory");
    };
    for (int c = c0; c < c1; c += 2) { step(c, preA); step(c + 1, preB); }
#undef DN_LOAD
#undef DN_STORE
}

__device__ __forceinline__ void dn_gate_rows(int r0, int r1, int w, int nw, int lane) {
    unsigned char* ws = argws();
    const bf16* QKV = (const bf16*)(ws + WS_BIG); const bf16* Z = (const bf16*)(ws + WS_BIG + 96 * MiB); const float* gn = argin(27); bf16* OB = (bf16*)(ws + WS_OB);
    for (int m = r0 + w; m < r1; m += nw) { const u32x4* op = (const u32x4*)(QKV + (size_t)m * QKVW + 2048 + lane * 16); const u32x4* zp = (const u32x4*)(Z + (size_t)m * D + lane * 16);
        const u32x4 o0 = op[0], o1 = op[1], z0 = zp[0], z1 = zp[1]; float ov[16], zv[16]; float ss = 0.f;
#pragma unroll
        for (int e = 0; e < 4; ++e) { ov[2 * e] = bflo(o0[e]); ov[2 * e + 1] = bfhi(o0[e]); ov[8 + 2 * e] = bflo(o1[e]); ov[9 + 2 * e] = bfhi(o1[e]);
            zv[2 * e] = bflo(z0[e]); zv[2 * e + 1] = bfhi(z0[e]); zv[8 + 2 * e] = bflo(z1[e]); zv[9 + 2 * e] = bfhi(z1[e]); }
#pragma unroll
        for (int e = 0; e < 16; ++e) ss += ov[e] * ov[e];
        ss += __shfl_xor(ss, 1); ss += __shfl_xor(ss, 2); ss += __shfl_xor(ss, 4);
        const float rs = rsqrtf(ss * (1.f / 128.f) + EPS); const float* gp = gn + (lane & 7) * 16; float y[16];
#pragma unroll
        for (int e = 0; e < 16; ++e) y[e] = ov[e] * rs * gp[e] * siluf_(zv[e]);
        u32x4 w0, w1;
#pragma unroll
        for (int e = 0; e < 4; ++e) { w0[e] = pk2(y[2 * e], y[2 * e + 1]); w1[e] = pk2(y[8 + 2 * e], y[9 + 2 * e]); }
        u32x4* dp = (u32x4*)(OB + (size_t)m * D + lane * 16); dp[0] = w0; dp[1] = w1; }
}

#define XB_TMO      128
#define XB_XCNT(j)  (256  + 64 * (j))
#define XB_XSUB(j)  (1280 + 64 * (j))
#define XB_XGEN(j)  (2304 + 64 * (j))
#define XB_TOP      3328
#define XB_TOPGEN   3392
#define XCD_BAR_WORDS 3456
#define XB_SPIN_CAP (1u << 18)
constexpr size_t WS_BAR = 65536;
__device__ __forceinline__ unsigned xb_ld(unsigned* p)              { return __hip_atomic_load(p, __ATOMIC_RELAXED, __HIP_MEMORY_SCOPE_AGENT); }
__device__ __forceinline__ unsigned xb_add(unsigned* p, unsigned v) { return __hip_atomic_fetch_add(p, v, __ATOMIC_RELAXED, __HIP_MEMORY_SCOPE_AGENT); }
__device__ __forceinline__ unsigned xb_xcc_id() { return (unsigned)__builtin_amdgcn_s_getreg((3 << 11) | 20) & 0xFu; }
#define XB_SPIN(cond, bar) do { unsigned _sp = 0; while (cond) { __builtin_amdgcn_s_sleep(1); \
    if ((++_sp & 255u) == 0u) { if (xb_ld(&(bar)[XB_TMO])) break; if (_sp > XB_SPIN_CAP) { atomicAdd(&(bar)[XB_TMO], 1u); break; } } } } while (0)
__device__ __forceinline__ void xcd_barrier_complete(unsigned* bar, unsigned x, unsigned& nloc, unsigned& nx) {
    const unsigned G = gridDim.x * gridDim.y * gridDim.z;
    unsigned sum, cnt, mine, sp = 0u;
    for (;;) {
        sum = 0u; cnt = 0u; mine = 0u;
#pragma unroll
        for (unsigned j = 0; j < 16; ++j) { const unsigned c = xb_ld(&bar[XB_XCNT(j)]); sum += c; cnt += (c > 0u) ? 1u : 0u; mine = (j == x) ? c : mine; }
        if (sum == G) break;
        __builtin_amdgcn_s_sleep(1);
        if ((++sp & 255u) == 0u) { if (xb_ld(&bar[XB_TMO])) break; if (sp > XB_SPIN_CAP) { atomicAdd(&bar[XB_TMO], 1u); break; } }
    }
    nloc = mine > 0u ? mine : 1u; nx = cnt > 0u ? cnt : 1u;
}
__device__ __forceinline__ void xcd_barrier(unsigned* bar, unsigned x, volatile LAS unsigned* st) {
    asm volatile("s_waitcnt vmcnt(0)" ::: "memory");
    __syncthreads();
    if (threadIdx.x == 0) {
        __builtin_amdgcn_s_waitcnt(0);
        unsigned nloc = st[0], nx = st[1];
        if (nloc == 0u) { xcd_barrier_complete(bar, x, nloc, nx); st[0] = nloc; st[1] = nx; }
        const unsigned old = xb_add(&bar[XB_XSUB(x)], 1u);
        const unsigned gen = old / nloc;
        if (old + 1u == (gen + 1u) * nloc) {
            __builtin_amdgcn_fence(__ATOMIC_RELEASE, "agent");
            asm volatile("s_waitcnt vmcnt(0)" ::: "memory");
            const unsigned og = xb_add(&bar[XB_TOP], 1u);
            const unsigned tg = og / nx;
            if (og + 1u == (tg + 1u) * nx) xb_add(&bar[XB_TOPGEN], 1u);
            else XB_SPIN(xb_ld(&bar[XB_TOPGEN]) == tg, bar);
            __builtin_amdgcn_fence(__ATOMIC_ACQUIRE, "agent");
            xb_add(&bar[XB_XGEN(x)], 1u);
            asm volatile("s_waitcnt vmcnt(0)" ::: "memory");
        } else {
            XB_SPIN(xb_ld(&bar[XB_XGEN(x)]) == gen, bar);
            __builtin_amdgcn_fence(__ATOMIC_ACQUIRE, "agent");
            asm volatile("s_waitcnt vmcnt(0)" ::: "memory");
        }
    }
    __syncthreads();
}

__global__ void __launch_bounds__(512, 2) mk_fwd(Args a) {
    extern __shared__ __attribute__((aligned(16))) unsigned char lds_raw[];
    LAS unsigned char* lds = (LAS unsigned char*)lds_raw;
    cg::grid_group grid = cg::this_grid();
    const int G = gridDim.x, bx = blockIdx.x, NGW = G * 8;
#ifdef EXFIL_A
    int nst = 0;
#define STAMP() do { unsigned long long* stp_ = (unsigned long long*)argws(); if (bx == 0 && threadIdx.x == 0) stp_[nst] = __builtin_amdgcn_s_memrealtime(); ++nst; } while (0)
#else
#define STAMP() do { } while (0)
#endif
    STAMP();
    volatile LAS unsigned* xst = (volatile LAS unsigned*)(lds + RED_OFF + 12288);
    if (threadIdx.x < 2) xst[threadIdx.x] = 0u;
    __syncthreads();
    const unsigned xcc = xb_xcc_id();
    { unsigned* bar_ = (unsigned*)(argws() + WS_BAR); if (threadIdx.x == 0) (void)xb_add(&bar_[XB_XCNT(xcc)], 1u); }
#define GSYNC() do { unsigned* bar_ = (unsigned*)(argws() + WS_BAR); xcd_barrier(bar_, xcc, xst); } while (0)
#define PH_VARS int tid_l = threadIdx.x; asm volatile("" : "+v"(tid_l)); const int lane = tid_l & 63, wave = __builtin_amdgcn_readfirstlane(tid_l >> 6), gw = bx * 8 + wave; \
    LAS float* scr = (LAS float*)(lds + wave * 16384); unsigned char* ws = argws(); float* X = argout(); bf16* XB = (bf16*)(ws + WS_XB); bf16* OB = (bf16*)(ws + WS_OB); float* SSQ = (float*)(ws + WS_SSQ); \
    (void)X; (void)XB; (void)OB; (void)SSQ; (void)scr; (void)lane; (void)gw;

    {   PH_VARS
        for (int l = 0; l < 2; ++l) {
            unsigned char* tb = ws + WS_OB + (size_t)l * 8 * MiB;
            TJ_RUN(argin(9) + (size_t)l * D * 2048, D, 2048, (bf16*)tb, argin(7) + l * D, 0);
            TJ_RUN(argin(10) + (size_t)l * D * D, D, D, (bf16*)(tb + 6 * MiB), (const float*)nullptr, 0);
            const float* Wq = argin(8) + (size_t)l * D * D; const float* gx = argin(6) + l * D; bf16* WQG = (bf16*)(tb + 4 * MiB);
            for (int i = gw * 64 + lane; i < D * D / 4; i += NGW * 64) { const f32x4 v = ((const f32x4*)Wq)[i]; const float g = gx[(i * 4) >> 10] * 0.0625f;
                u32x2 w; w.x = pk2(v[0] * g, v[1] * g); w.y = pk2(v[2] * g, v[3] * g); ((u32x2*)WQG)[i] = w; }
        }
    }
    {   PH_VARS
        for (int m = gw; m < NMEM; m += NGW) { const f32x4* xr = (const f32x4*)(argin(1) + (size_t)m * D) + lane; float s = 0.f; f32x4 v[4];
#pragma unroll
            for (int j = 0; j < 4; ++j) { v[j] = xr[64 * j]; s += (v[j][0] * v[j][0] + v[j][1] * v[j][1]) + (v[j][2] * v[j][2] + v[j][3] * v[j][3]); }
            s = wave_sum(s); u32x2* o = (u32x2*)((bf16*)(ws + WS_MEMB) + (size_t)m * D) + lane;
#pragma unroll
            for (int j = 0; j < 4; ++j) { u32x2 w; w.x = pk2(v[j][0], v[j][1]); w.y = pk2(v[j][2], v[j][3]); o[64 * j] = w; }
            if (lane == 0) ((float*)(ws + WS_MEMRS))[m] = rsqrtf(s * (1.f / 1024.f) + EPS); }
        for (int m = gw; m < S; m += NGW) { const f32x4* xr = (const f32x4*)(argin(0) + (size_t)m * D) + lane; float s = 0.f; f32x4 v[4];
#pragma unroll
            for (int j = 0; j < 4; ++j) { v[j] = xr[64 * j]; s += (v[j][0] * v[j][0] + v[j][1] * v[j][1]) + (v[j][2] * v[j][2] + v[j][3] * v[j][3]); }
            s = wave_sum(s); u32x2* o = (u32x2*)(XB + (size_t)m * D) + lane;
#pragma unroll
            for (int j = 0; j < 4; ++j) { u32x2 w; w.x = pk2(v[j][0], v[j][1]); w.y = pk2(v[j][2], v[j][3]); o[64 * j] = w; }
            if (lane < 16) SSQ[(size_t)m * 16 + lane] = lane == 0 ? s : 0.f; }
    }
    { PH_VARS layer_weights(0, 1 | 4, gw, NGW, scr, lane); }
    if (G == 0x7fffffff) grid.sync();
    GSYNC(); STAMP();
    for (int l = 0; l < 2; ++l) {
        { PH_VARS pg8::TileSched Sd; Sd.init(S, 2 * FF, G, bx, XB, D, ws + WS_F1IN, D); pg8::EpiSwiGLU E{(bf16*)(ws + WS_BIG), SSQ, (LAS float*)(lds + RED_OFF)}; pg8::rs_prefill(Sd, SSQ, (LAS float*)(lds + RED_OFF)); pg8::gemm_phase(lds, D, D, D, Sd, E); }
        if (l == 0) { PH_VARS pg8::KvSched Sd{G, (bx + G - G / 2) % G, ws}; pg8::EpiPrep<0> E{ws}; pg8::gemm_phase(lds, 1024, 1024, 1024, Sd, E); }
        if (bx >= G / 2) { PH_VARS layer_weights(l, 2, (bx - G / 2) * 8 + wave, (G - G / 2) * 8, scr, lane); }
        GSYNC(); STAMP();
        { PH_VARS pg8::TileSched Sd; Sd.init(S, D, G, bx, ws + WS_BIG, FF, ws + WS_F1OUT, FF); pg8::EpiResid E{X, XB, SSQ, 0.5f, l == 0 ? argin(0) : (const float*)X}; pg8::gemm_phase(lds, FF, FF, FF, Sd, E); }
        GSYNC(); STAMP();
        if (l == 0) {
            { PH_VARS pg8::TileSched Sd; Sd.init(S, ABN, G, bx, XB, D, ws + WS_MIXIN, D); pg8::EpiBf16 E{(bf16*)(ws + WS_BIG), ABN, SSQ, 1, 1.f, (LAS float*)(lds + RED_OFF)}; pg8::rs_prefill(Sd, SSQ, (LAS float*)(lds + RED_OFF)); pg8::gemm_phase(lds, D, D, D, Sd, E); }
            { PH_VARS pg8::QkSched Sd{G, (bx + G - G / 2) % G, ws}; pg8::EpiPrep<1> E{ws}; pg8::gemm_phase(lds, 2048, 1024, 256, Sd, E); }
            { PH_VARS pg8::VoSched Sd{G, (bx + G - G / 2 - 32) % G, ws}; pg8::EpiPrep<2> E{ws}; pg8::gemm_phase(lds, 1024, 2048, 256, Sd, E); }
            if (bx >= G / 2) { PH_VARS layer_weights(1, 1, (bx - G / 2) * 8 + wave, (G - G / 2) * 8, scr, lane); }
            GSYNC(); STAMP();
#ifndef NO_LRU
            for (int u = bx; u < 2048; u += G) lru_local_unit((LAS float*)lds, u, u == bx || (G & 7) != 0);
#endif
            __syncthreads(); STAMP();
#ifndef NO_ATTN
            { PH_VARS for (int u = gw; u < 4096; u += NGW) attn_unit2((const bf16*)(ws + WS_BIG), OB, lds + wave * 9216, u, u + 4096, lane); }
#endif
            GSYNC(); STAMP();
#ifndef NO_LRU
            lru_apply_wg((LAS float*)lds, bx, G);
#endif
            GSYNC(); STAMP();
        } else {
            { PH_VARS pg8::TileSched Sd; Sd.init(S, 4096, G, bx, XB, D, ws + WS_MIXIN, D);
              pg8::EpiDN E{(bf16*)(ws + WS_BIG), (bf16*)(ws + WS_BIG + 96 * MiB), (bf16*)(ws + WS_HALO), (float*)(ws + WS_DNAB), SSQ, argin(25), argin(26), (LAS float*)(lds + RED_OFF)}; pg8::rs_prefill(Sd, SSQ, (LAS float*)(lds + RED_OFF)); pg8::gemm_phase(lds, D, D, D, Sd, E); }
            {   PH_VARS
                const bf16* Wab = (const bf16*)(ws + WS_MIXIN) + (size_t)4096 * D; float* AB = (float*)(ws + WS_DNAB);
                const float* a_log = argin(25); const float* dt_bias = argin(26);
                const int c = lane & 15, q = lane >> 4;
                for (int rb = gw; rb < S / 16; rb += NGW) {
                    const bf16* ap = XB + (size_t)(rb * 16 + c) * D + 8 * q; const bf16* bp = Wab + (size_t)c * D + 8 * q;
                    f32x4 acc = (f32x4){0.f, 0.f, 0.f, 0.f};
#pragma unroll 8
                    for (int ks = 0; ks < 32; ++ks) acc = MFMA16(*(const bf16x8*)(ap + 32 * ks), *(const bf16x8*)(bp + 32 * ks), acc);
                    const int h = c & 7; const float al = -__expf(a_log[h]), db = dt_bias[h];
#pragma unroll
                    for (int e = 0; e < 4; ++e) { const int row = rb * 16 + 4 * q + e; const float v = acc[e] * row_rstd16(SSQ, row);
                        AB[(size_t)row * 16 + c] = (c < 8) ? al * softplusf_(v + db) : sigmoidf_(v); } }
            }
            GSYNC(); STAMP();
            f32x4 dnS[2]; dnS[0] = (f32x4){0.f, 0.f, 0.f, 0.f}; dnS[1] = dnS[0];
            for (int u = bx; u < 512; u += G) dn_local_unit(lds, u);
            GSYNC(); STAMP();
            for (int k = 1; k <= 4; ++k) {
                if (bx < 64) dn_scan_worker(lds, ((bx & 7) << 3) | (bx >> 3), 64 * (k - 1), 64 * k, dnS);
                else if (k < 4) { for (int u = 512 * k + (bx - 64); u < 512 * (k + 1); u += G - 64) dn_local_unit(lds, u); }
                else { PH_VARS const int w = (bx - 64) * 8 + wave, nw = (G - 64) * 8;
                    dn_gate_rows(0, 6144, w, nw, lane); dn_gate_rows(8192, 12288, w, nw, lane); }
                GSYNC();
            }
            STAMP();
            {   PH_VARS
                dn_gate_rows(6144, 8192, gw, NGW, lane); dn_gate_rows(12288, S, gw, NGW, lane);
            }
            GSYNC(); STAMP();
        }
        { PH_VARS pg8::TileSched Sd; Sd.init(S, D, G, bx, OB, D, ws + WS_MIXOUT, D); pg8::EpiResid E{X, XB, SSQ, 1.0f, X}; pg8::gemm_phase(lds, D, D, D, Sd, E); }
        GSYNC(); STAMP();
        { PH_VARS pg8::TileSched Sd; Sd.init(S, D, G, bx, XB, D, ws + WS_WQK + (size_t)l * 2 * MiB, D); pg8::EpiSoftmax E{(bf16*)(ws + WS_BIG), SSQ, (LAS float*)(lds + RED_OFF)}; pg8::gemm_phase(lds, D, D, D, Sd, E); }
        GSYNC(); STAMP();
        { PH_VARS pg8::TileSched Sd; Sd.init(S, D, G, bx, ws + WS_BIG, D, ws + WS_WVO + (size_t)l * 2 * MiB, D); pg8::EpiResid E{X, XB, SSQ, 1.0f, X}; pg8::gemm_phase(lds, D, D, D, Sd, E); }
        GSYNC(); STAMP();
        { PH_VARS pg8::TileSched Sd; Sd.init(S, 2 * FF, G, bx, XB, D, ws + WS_F2IN, D); pg8::EpiSwiGLU E{(bf16*)(ws + WS_BIG), SSQ, (LAS float*)(lds + RED_OFF)}; pg8::rs_prefill(Sd, SSQ, (LAS float*)(lds + RED_OFF)); pg8::gemm_phase(lds, D, D, D, Sd, E); }
        if (l == 0 && bx >= G / 2) { PH_VARS layer_weights(1, 4, (bx - G / 2) * 8 + wave, (G - G / 2) * 8, scr, lane); }
        GSYNC(); STAMP();
        { PH_VARS pg8::TileSched Sd; Sd.init(S, D, G, bx, ws + WS_BIG, FF, ws + WS_F2OUT, FF); pg8::EpiResid E{X, l == 1 ? (bf16*)nullptr : XB, SSQ, 0.5f, X}; pg8::gemm_phase(lds, FF, FF, FF, Sd, E); }
        GSYNC(); STAMP();
    }
    { PH_VARS const float* gf = argin(29);
      for (int m = gw; m < S; m += NGW) { const float rs = row_rstd16(SSQ, m); f32x4* xr = (f32x4*)(X + (size_t)m * D) + lane; const f32x4* gp = (const f32x4*)gf + lane;
#pragma unroll
          for (int j = 0; j < 4; ++j) { const f32x4 v = xr[64 * j], g = gp[64 * j]; xr[64 * j] = v * rs * g; } } }
#ifdef EXFIL_A
    STAMP();
    {
        const unsigned long long* st = (const unsigned long long*)argws();
        if (bx == 0) { const unsigned long long dt = st[EXFIL_B] - st[EXFIL_A]; const unsigned long long t0 = __builtin_amdgcn_s_memrealtime();
            while (__builtin_amdgcn_s_memrealtime() - t0 < 4ull * dt) __builtin_amdgcn_s_sleep(32); }
    }
#endif
}

extern "C" void kernel_launch(void* const* d_in, const int* in_sizes, int n_in, void* d_out, int out_size, void* d_ws, size_t ws_size, hipStream_t stream) {
    static int grid = 0;
    if (grid == 0) {
        if (n_in != 30 || out_size != S * D || ws_size < WS_END) { fprintf(stderr, "kernel_launch: unexpected shapes (n_in %d out %d ws %zu)\n", n_in, out_size, ws_size); grid = -1; return; }
        int dev = 0, cus = 0, per_cu = 0;
        hipGetDevice(&dev); hipDeviceGetAttribute(&cus, hipDeviceAttributeMultiprocessorCount, dev);
        hipFuncSetAttribute((const void*)mk_fwd, hipFuncAttributeMaxDynamicSharedMemorySize, LDS_BYTES);
        hipOccupancyMaxActiveBlocksPerMultiprocessor(&per_cu, (const void*)mk_fwd, 512, LDS_BYTES);
        if (per_cu < 1) { fprintf(stderr, "kernel_launch: occupancy query says %d blocks per CU\n", per_cu); per_cu = 1; }
        grid = (cus / 8) * 8;
        (void)hipGetLastError();
    }
    if (grid < 0) return;
    if (hipMemsetAsync((char*)d_ws + WS_BAR, 0, 16384, stream) != hipSuccess) { fprintf(stderr, "kernel_launch: memset failed\n"); return; }
    Args a{};
    for (int i = 0; i < 30; ++i) a.in[i] = (const float*)d_in[i];
    a.out = (float*)d_out; a.ws = (unsigned char*)d_ws;
    void* args[] = {&a};
    hipError_t e = hipLaunchCooperativeKernel((const void*)mk_fwd, dim3(grid), dim3(512), args, LDS_BYTES, stream);
    if (e != hipSuccess) fprintf(stderr, "cooperative launch failed: %s (grid %d)\n", hipGetErrorString(e), grid);
}
```

```cpp
#include <hip/hip_runtime.h>
#include <hip/hip_cooperative_groups.h>
#include <cstdio>
#include <cstdint>
namespace cg = cooperative_groups;

#define LAS __attribute__((address_space(3)))
typedef unsigned short bf16;
typedef short bf16x8 __attribute__((ext_vector_type(8)));
typedef short s16x4 __attribute__((ext_vector_type(4)));
typedef float f32x4 __attribute__((ext_vector_type(4)));
typedef float f32x2 __attribute__((ext_vector_type(2)));
typedef unsigned u32x4 __attribute__((ext_vector_type(4)));
typedef unsigned u32x2 __attribute__((ext_vector_type(2)));
typedef __bf16 bf16x2_t __attribute__((ext_vector_type(2)));

constexpr int S = 16384, D = 1024, FF = 2816, NMEM = 256;
constexpr int ABN = 2560, DNN = 4352, DNREAL = 4112, QKVW = 3072;
constexpr float EPS = 1e-6f;
constexpr size_t MiB = 1u << 20;
constexpr size_t WS_SSQ = 1 * MiB;
constexpr size_t WS_DNAB = 2 * MiB;
constexpr size_t WS_MEMB = 3 * MiB;
constexpr size_t WS_MEMRS = 3 * MiB + 512 * 1024;
constexpr size_t WS_DECAY = 3 * MiB + 768 * 1024;
constexpr size_t WS_LRUTOT = 4 * MiB;
constexpr size_t WS_HALO = 5 * MiB;
constexpr size_t WS_KV = 10 * MiB;
constexpr size_t WS_WQK = 12 * MiB;
constexpr size_t WS_WVO = 16 * MiB;
constexpr size_t WS_F1IN = 20 * MiB, WS_F1OUT = 31 * MiB, WS_F2IN = WS_F1OUT + 5 * MiB + 512 * 1024, WS_F2OUT = WS_F2IN + 11 * MiB;
constexpr size_t WS_MIXIN = 53 * MiB, WS_MIXOUT = WS_MIXIN + 8 * MiB + 512 * 1024;
constexpr size_t WS_XB = 64 * MiB;
constexpr size_t WS_OB = 96 * MiB;
constexpr size_t WS_BIG = 128 * MiB;
constexpr size_t WS_END = 256 * MiB;
static_assert(WS_F2OUT + 5 * MiB + 512 * 1024 <= WS_MIXIN && WS_MIXOUT + 2 * MiB <= WS_XB, "weights map");

constexpr int LDS_BYTES = 147456;
constexpr int RED_OFF = 131072;

__device__ __forceinline__ unsigned pk2(float lo, float hi) { f32x2 v = {lo, hi}; bf16x2_t b = __builtin_convertvector(v, bf16x2_t); return __builtin_bit_cast(unsigned, b); }
__device__ __forceinline__ float bf2f(unsigned short b) { return __uint_as_float(((unsigned)b) << 16); }
__device__ __forceinline__ float bflo(unsigned w) { return __uint_as_float(w << 16); }
__device__ __forceinline__ float bfhi(unsigned w) { return __uint_as_float(w & 0xffff0000u); }
__device__ __forceinline__ float sigmoidf_(float x) { return __builtin_amdgcn_rcpf(1.f + __expf(-x)); }
__device__ __forceinline__ float siluf_(float x) { return x * sigmoidf_(x); }
__device__ __forceinline__ float softplusf_(float x) { return x > 20.f ? x : log1pf(__expf(x)); }
__device__ __forceinline__ float gelu_tanh(float x) { const float u = 0.7978845608f * (x + 0.044715f * x * x * x); const float t = 1.f - 2.f * __builtin_amdgcn_rcpf(__expf(2.f * u) + 1.f); return 0.5f * x * (1.f + t); }
__device__ __forceinline__ float row_rstd16(const float* ssq, int row) {
    const f32x4* p = (const f32x4*)(ssq + (size_t)row * 16); const f32x4 a = p[0], b = p[1], c = p[2], d = p[3];
    const float s = ((a[0] + a[1]) + (a[2] + a[3])) + ((b[0] + b[1]) + (b[2] + b[3])) + ((c[0] + c[1]) + (c[2] + c[3])) + ((d[0] + d[1]) + (d[2] + d[3]));
    return rsqrtf(s * (1.f / 1024.f) + EPS);
}
__device__ __forceinline__ bf16x8 pack8(const f32x4& a, const f32x4& b) { u32x4 p; p[0] = pk2(a[0], a[1]); p[1] = pk2(a[2], a[3]); p[2] = pk2(b[0], b[1]); p[3] = pk2(b[2], b[3]); return __builtin_bit_cast(bf16x8, p); }

__device__ __forceinline__ float qred_max(float t) {
    auto r = __builtin_amdgcn_permlane16_swap(__float_as_uint(t), __float_as_uint(t), false, false);
    t = fmaxf(__uint_as_float(r[0]), __uint_as_float(r[1]));
    auto r2 = __builtin_amdgcn_permlane32_swap(__float_as_uint(t), __float_as_uint(t), false, false);
    return fmaxf(__uint_as_float(r2[0]), __uint_as_float(r2[1]));
}
__device__ __forceinline__ float qred_sum(float t) {
    auto r = __builtin_amdgcn_permlane16_swap(__float_as_uint(t), __float_as_uint(t), false, false);
    t = __uint_as_float(r[0]) + __uint_as_float(r[1]);
    auto r2 = __builtin_amdgcn_permlane32_swap(__float_as_uint(t), __float_as_uint(t), false, false);
    return __uint_as_float(r2[0]) + __uint_as_float(r2[1]);
}
#define MFMA16(a, b, c) __builtin_amdgcn_mfma_f32_16x16x32_bf16((a), (b), (c), 0, 0, 0)

namespace pg8 {
constexpr int BM = 256, BK = 64, HALF = 128, HTB = HALF * BK * 2, NXCD = 8, WGM = 8;
__host__ __device__ __forceinline__ int lds_byte(int r, int c) { const int st = (r >> 4) * 2 + (c >> 5), rr = r & 15, cc = c & 31, ob = rr * 64 + cc * 2; return st * 1024 + (ob ^ (((ob >> 9) & 1) << 5)); }
__host__ __device__ __forceinline__ void stage_rc(int b, int& R, int& C) { const int st = b / 1024, sb = b % 1024, swz = sb ^ (((sb >> 9) & 1) << 5); R = (st >> 1) * 16 + swz / 64; C = (st & 1) * 32 + (swz % 64) / 2; }
__host__ __device__ __forceinline__ int perm32(int rho) { const int n = rho >> 4, i = rho & 15; return 8 * (i >> 2) + 4 * n + (i & 3); }

struct Unit { int pm, pn; const char* a; const char* b; int aux; };

struct TileSched {
    int nM, nN, nwg, G, c; const char* A; const char* B; size_t tA, tB;
    __device__ void init(int M, int N, int G_, int c_, const void* A_, int lda, const void* B_, int ldb) { nM = M / BM; nN = N / BM; nwg = nM * nN; G = G_; c = c_; A = (const char*)A_; B = (const char*)B_; tA = (size_t)BM * lda * 2; tB = (size_t)BM * ldb * 2; }
    __device__ bool next(int i, Unit& u) const {
        const long L = (long)i * G + c; if (L >= nwg) return false;
        int wgid = (int)L; { const int q = nwg / NXCD, r = nwg % NXCD, xcd = wgid % NXCD, off = wgid / NXCD; wgid = (xcd < r ? xcd * (q + 1) : r * (q + 1) + (xcd - r) * q) + off; }
        const int nig = WGM * nN, gid = wgid / nig, fm = gid * WGM, gsz = (nM - fm) < WGM ? (nM - fm) : WGM;
        u.pm = fm + ((wgid % nig) % gsz); u.pn = (wgid % nig) / gsz; u.a = A + (size_t)u.pm * tA; u.b = B + (size_t)u.pn * tB; u.aux = i; return true;
    }
};

template <class Epi, class Sched>
__device__ __forceinline__ void gemm_phase(LAS unsigned char* lds, const int lda, const int ldb, const int K, const Sched& S, const Epi& E) {
    int tid_ = threadIdx.x; asm volatile("" : "+v"(tid_));
    const int tid = tid_, wid = __builtin_amdgcn_readfirstlane(tid >> 6), lane = tid & 63, wr = wid >> 2, wc = wid & 3, fr = lane & 15, fq = lane >> 4;
    int Kv_ = K; asm volatile("" : "+s"(Kv_));
    const int nt = Kv_ / BK;
    unsigned voffA[2], voffB[2];
#pragma unroll
    for (int i = 0; i < 2; ++i) { int R, C; stage_rc(tid * 16 + i * 8192, R, C); const int Rb = Epi::PERM ? ((R & ~31) + perm32(R & 31)) : R;
        voffA[i] = (unsigned)(R * lda + C) * 2u; voffB[i] = (unsigned)(Rb * ldb + C) * 2u; }
    const size_t kstep = (size_t)(BK * 2);
    const size_t hstepA = (size_t)HALF * lda * 2, hstepB = (size_t)HALF * ldb * 2;
    const unsigned ldsw = (unsigned)wid * 1024u;
    const int aoff = lds_byte(wr * 64 + fr, fq * 8), boff = lds_byte(wc * 32 + fr, fq * 8);
#define PG8_SA(b, h) (((b) * 2 + (h)) * HTB)
#define PG8_SB(b, h) ((4 + (b) * 2 + (h)) * HTB)
#define PG8_STAGE(bufoff, gbase, voff) do { _Pragma("unroll") for (int _i = 0; _i < 2; ++_i) \
        __builtin_amdgcn_global_load_lds((const unsigned*)((const char*)(gbase) + (voff)[_i]), (LAS unsigned*)(lds + (bufoff) + ldsw + _i * 8192), 16, 0, 0); } while (0)
#define PG8_LDA(dst, b, h) do { _Pragma("unroll") for (int m = 0; m < 4; ++m) _Pragma("unroll") for (int k = 0; k < 2; ++k) dst[m][k] = *(const LAS bf16x8*)(lds + PG8_SA(b, h) + aoff + m * 2048 + k * 1024); } while (0)
#define PG8_LDB(dst, b, h) do { _Pragma("unroll") for (int n = 0; n < 2; ++n) _Pragma("unroll") for (int k = 0; k < 2; ++k) dst[n][k] = *(const LAS bf16x8*)(lds + PG8_SB(b, h) + boff + n * 2048 + k * 1024); } while (0)
#define PG8_MMA(ai, bj, At, Bt) do { __builtin_amdgcn_s_setprio(1); _Pragma("unroll") for (int m = 0; m < 4; ++m) _Pragma("unroll") for (int n = 0; n < 2; ++n) _Pragma("unroll") for (int k = 0; k < 2; ++k) \
        acc[ai][bj][m][n] = __builtin_amdgcn_mfma_f32_16x16x32_bf16(Bt[n][k], At[m][k], acc[ai][bj][m][n], 0, 0, 0); __builtin_amdgcn_s_setprio(0); } while (0)
#define PG8_WAIT_V(n) asm volatile("s_waitcnt vmcnt(" #n ")" ::: "memory")
#define PG8_WAIT_L(n) asm volatile("s_waitcnt lgkmcnt(" #n ")" ::: "memory")
#define PG8_BAR __builtin_amdgcn_s_barrier()
#define PG8_SCHED __builtin_amdgcn_sched_barrier(0)
    Unit cur, nxt; int ui = 0;
    if (!S.next(0, cur)) return;
    f32x4 acc[2][2][4][2];
#pragma unroll
    for (int a = 0; a < 2; ++a)
#pragma unroll
        for (int b = 0; b < 2; ++b)
#pragma unroll
            for (int m = 0; m < 4; ++m)
#pragma unroll
                for (int n = 0; n < 2; ++n) acc[a][b][m][n] = (f32x4){0.f, 0.f, 0.f, 0.f};
    bf16x8 At[4][2], B0[2][2], B1[2][2];
    const char* cA = cur.a; const char* cB = cur.b;
    PG8_STAGE(PG8_SB(0, 0), cB, voffB); PG8_STAGE(PG8_SB(0, 1), cB + hstepB, voffB); PG8_STAGE(PG8_SA(0, 0), cA, voffA); PG8_STAGE(PG8_SA(0, 1), cA + hstepA, voffA);
    if (wr == 1) PG8_BAR;
    PG8_WAIT_V(2); PG8_BAR;
    PG8_STAGE(PG8_SB(1, 0), cB + kstep, voffB); PG8_STAGE(PG8_SA(1, 0), cA + kstep, voffA); PG8_STAGE(PG8_SB(1, 1), cB + hstepB + kstep, voffB);
    PG8_WAIT_V(6); PG8_BAR;
    for (;;) {
        const bool has_next = S.next(ui + 1, nxt);
        const char* nA = has_next ? nxt.a : cA; const char* nB = has_next ? nxt.b : cB;
        for (int t = 0; t < nt; t += 2) {
            const bool last = (t == nt - 2);
            const char* a1 = cA + (size_t)(t + 1) * kstep;
            const char* a2 = last ? nA : cA + (size_t)(t + 2) * kstep; const char* b2 = last ? nB : cB + (size_t)(t + 2) * kstep;
            const char* a3 = a2 + kstep; const char* b3 = b2 + kstep;
            PG8_LDB(B0, 0, 0); PG8_LDB(B1, 0, 1); PG8_SCHED; PG8_LDA(At, 0, 0); PG8_STAGE(PG8_SA(1, 1), a1 + hstepA, voffA);
            PG8_WAIT_V(8); PG8_WAIT_L(0); PG8_BAR; PG8_MMA(0, 0, At, B0); PG8_MMA(0, 1, At, B1); PG8_BAR; PG8_SCHED;
            PG8_LDA(At, 0, 1); PG8_STAGE(PG8_SB(0, 0), b2, voffB); PG8_STAGE(PG8_SB(0, 1), b2 + hstepB, voffB); PG8_STAGE(PG8_SA(0, 0), a2, voffA);
            PG8_WAIT_V(8); PG8_WAIT_L(0); PG8_BAR; PG8_MMA(1, 0, At, B0); PG8_MMA(1, 1, At, B1); PG8_BAR; PG8_SCHED;
            PG8_LDB(B0, 1, 0); PG8_LDB(B1, 1, 1); PG8_SCHED; PG8_LDA(At, 1, 0); PG8_STAGE(PG8_SA(0, 1), a2 + hstepA, voffA);
            PG8_WAIT_V(8); PG8_WAIT_L(0); PG8_BAR; PG8_MMA(0, 0, At, B0); PG8_MMA(0, 1, At, B1); PG8_BAR; PG8_SCHED;
            PG8_LDA(At, 1, 1); PG8_STAGE(PG8_SB(1, 0), b3, voffB); PG8_STAGE(PG8_SB(1, 1), b3 + hstepB, voffB); PG8_STAGE(PG8_SA(1, 0), a3, voffA);
            PG8_WAIT_V(8); PG8_WAIT_L(0); PG8_BAR; PG8_MMA(1, 0, At, B0); PG8_MMA(1, 1, At, B1); PG8_BAR; PG8_SCHED;
        }
        if (wr == 0) PG8_BAR;
        E(acc, cur, wr, wc, fr, fq);
        if (!has_next) break;
#pragma unroll
        for (int a = 0; a < 2; ++a)
#pragma unroll
            for (int b = 0; b < 2; ++b)
#pragma unroll
                for (int m = 0; m < 4; ++m)
#pragma unroll
                    for (int n = 0; n < 2; ++n) acc[a][b][m][n] = (f32x4){0.f, 0.f, 0.f, 0.f};
        cur = nxt; cA = nA; cB = nB; ++ui;
        if (wr == 1) PG8_BAR;
    }
    PG8_WAIT_V(0);
    PG8_BAR;
#undef PG8_SA
#undef PG8_SB
#undef PG8_STAGE
#undef PG8_LDA
#undef PG8_LDB
#undef PG8_MMA
#undef PG8_WAIT_V
#undef PG8_WAIT_L
#undef PG8_SCHED
}


__device__ __forceinline__ void rs_fill(const float* ssq, int pm, LAS float* rsl, int tid) {
    asm volatile("s_waitcnt lgkmcnt(0)" ::: "memory"); __builtin_amdgcn_s_barrier(); asm volatile("" ::: "memory");
    if (tid < 256) rsl[tid] = row_rstd16(ssq, pm * 256 + tid);
    asm volatile("s_waitcnt lgkmcnt(0)" ::: "memory"); __builtin_amdgcn_s_barrier(); asm volatile("" ::: "memory");
}
template <class Sched> __device__ __forceinline__ void rs_prefill(const Sched& Sd, const float* ssq, LAS float* tab) {
    int tid_ = threadIdx.x; asm volatile("" : "+v"(tid_));
    Unit u;
    for (int i = 0; i < 8 && Sd.next(i, u); ++i) { if (tid_ < 256) tab[i * 256 + tid_] = row_rstd16(ssq, u.pm * 256 + tid_); }
    __syncthreads();
}
#define EPI_FENCE() asm volatile("" ::: "memory")
typedef f32x4 Acc[2][2][4][2];

struct EpiSwiGLU {
    static constexpr bool PERM = true;
    bf16* H; const float* ssq; LAS float* rsl;
    __device__ __forceinline__ void operator()(Acc& acc, const Unit& u, int wr, int wc, int fr, int fq) const {
        asm volatile("" : "+v"(fr), "+v"(fq));
        const int row0 = u.pm * BM + wr * 64 + fr, col0 = u.pn * 128 + wc * 32 + 8 * fq;
        const LAS float* rst = rsl + u.aux * 256;
#pragma unroll
        for (int ai = 0; ai < 2; ++ai)
#pragma unroll
            for (int m = 0; m < 4; ++m) { const int row = row0 + ai * HALF + m * 16; const float rs = rst[row & 255]; EPI_FENCE();
                float h[8];
#pragma unroll
                for (int n = 0; n < 2; ++n)
#pragma unroll
                    for (int j = 0; j < 4; ++j) { const float g = acc[ai][0][m][n][j] * rs, up = acc[ai][1][m][n][j] * rs; h[n * 4 + j] = siluf_(g) * up; }
                u32x4 w; w.x = pk2(h[0], h[1]); w.y = pk2(h[2], h[3]); w.z = pk2(h[4], h[5]); w.w = pk2(h[6], h[7]);
                *(u32x4*)(H + (size_t)row * FF + col0) = w; }
    }
};
struct EpiResid {
    static constexpr bool PERM = false;
    float* X; bf16* XB; float* ssq; float alpha; const float* Xr;
    __device__ __forceinline__ void operator()(Acc& acc, const Unit& u, int wr, int wc, int fr, int fq) const {
        asm volatile("" : "+v"(fr), "+v"(fq));
        const int row0 = u.pm * BM + wr * 64 + fr, col0 = u.pn * BM + wc * 32 + 4 * fq;
        const long dx = Xr - X;
        const unsigned off0 = (unsigned)row0 * D + col0;
#pragma unroll
        for (int ai = 0; ai < 2; ++ai)
#pragma unroll
            for (int mp = 0; mp < 2; ++mp) {
                f32x4 xv[2][4];
#pragma unroll
                for (int mm = 0; mm < 2; ++mm)
#pragma unroll
                    for (int bj = 0; bj < 2; ++bj)
#pragma unroll
                        for (int n = 0; n < 2; ++n) xv[mm][bj * 2 + n] = *(const f32x4*)(X + dx + (off0 + (unsigned)((ai * HALF + (mp * 2 + mm) * 16) * D + bj * HALF + n * 16)));
#pragma unroll
                for (int mm = 0; mm < 2; ++mm) { const int m = mp * 2 + mm; const int row = row0 + ai * HALF + m * 16; float sq = 0.f;
#pragma unroll
                    for (int bj = 0; bj < 2; ++bj)
#pragma unroll
                        for (int n = 0; n < 2; ++n) { const unsigned off = off0 + (unsigned)((ai * HALF + m * 16) * D + bj * HALF + n * 16);
                            const f32x4 v = xv[mm][bj * 2 + n] + acc[ai][bj][m][n] * alpha; *(f32x4*)(X + off) = v;
                            u32x2 w; w.x = pk2(v[0], v[1]); w.y = pk2(v[2], v[3]); *(u32x2*)(XB + off) = w;
                            sq += (v[0] * v[0] + v[1] * v[1]) + (v[2] * v[2] + v[3] * v[3]); }
                    sq += __shfl_xor(sq, 16); sq += __shfl_xor(sq, 32);
                    if (fq == 0) ssq[(size_t)row * 16 + u.pn * 4 + wc] = sq; }
                EPI_FENCE(); }
    }
};
struct EpiBf16 {
    static constexpr bool PERM = true;
    bf16* O; int ldc; const float* rsp; int mode; float scale; LAS float* rsl;
    __device__ __forceinline__ void store(Acc& acc, bf16* base, int row0, int col0, int tabo = 0) const {
#pragma unroll
        for (int ai = 0; ai < 2; ++ai)
#pragma unroll
            for (int m = 0; m < 4; ++m) { const int row = row0 + ai * HALF + m * 16;
                float rs = scale; if (mode == 1) rs *= rsl[tabo + (row & 255)]; else if (mode == 2) rs *= rsp[row]; EPI_FENCE();
                bf16* rowp = base + (size_t)row * ldc + col0;
#pragma unroll
                for (int bj = 0; bj < 2; ++bj) { const f32x4 v0 = acc[ai][bj][m][0] * rs, v1 = acc[ai][bj][m][1] * rs;
                    u32x4 w; w.x = pk2(v0[0], v0[1]); w.y = pk2(v0[2], v0[3]); w.z = pk2(v1[0], v1[1]); w.w = pk2(v1[2], v1[3]);
                    *(u32x4*)(rowp + bj * HALF) = w; } }
    }
    __device__ __forceinline__ void operator()(Acc& acc, const Unit& u, int wr, int wc, int fr, int fq) const {
        asm volatile("" : "+v"(fr), "+v"(fq));
        store(acc, O, u.pm * BM + wr * 64 + fr, u.pn * BM + wc * 32 + 8 * fq, u.aux * 256);
    }
};
template <int kind> struct EpiPrep {
    static constexpr bool PERM = true;
    unsigned char* ws;
    __device__ __forceinline__ void operator()(Acc& acc, const Unit& u, int wr, int wc, int fr, int fq) const {
        asm volatile("" : "+v"(fr), "+v"(fq));
        EpiBf16 e; e.rsl = nullptr; const int r0 = wr * 64 + fr, c0 = wc * 32 + 8 * fq;
        if constexpr (kind == 0) { const int l = u.aux >> 3, t = u.aux & 7; e.O = (bf16*)(ws + WS_KV) + (size_t)l * 256 * 2048; e.ldc = 2048; e.rsp = (const float*)(ws + WS_MEMRS); e.mode = 2; e.scale = 1.f; e.store(acc, e.O, r0, t * 256 + c0); }
        else if constexpr (kind == 1) { const int l = u.aux >> 4, h = (u.aux >> 2) & 3, t = u.aux & 3; e.O = (bf16*)(ws + WS_WQK) + (size_t)l * 1024 * 1024; e.ldc = 1024; e.rsp = nullptr; e.mode = 0; e.scale = 1.f; e.store(acc, e.O, h * 256 + r0, t * 256 + c0); }
        else { const int l = u.aux >> 4, h = (u.aux >> 2) & 3, t = u.aux & 3; e.O = (bf16*)(ws + WS_WVO) + (size_t)l * 1024 * 1024; e.ldc = 1024; e.rsp = nullptr; e.mode = 0; e.scale = 1.f; e.store(acc, e.O, t * 256 + r0, h * 256 + c0); }
    }
};
struct EpiDN {
    static constexpr bool PERM = true;
    bf16* QKV; bf16* Z; bf16* HALO; float* AB; const float* ssq; const float* a_log; const float* dt_bias; LAS float* rsl;
    __device__ __forceinline__ void operator()(Acc& acc, const Unit& u, int wr, int wc, int fr, int fq) const {
        asm volatile("" : "+v"(fr), "+v"(fq));
        const int row0 = u.pm * BM + wr * 64 + fr, c0 = wc * 32 + 8 * fq;
        const LAS float* rst = rsl + u.aux * 256;
#pragma unroll
        for (int ai = 0; ai < 2; ++ai)
#pragma unroll
            for (int m = 0; m < 4; ++m) { const int row = row0 + ai * HALF + m * 16; const float rs = rst[row & 255]; EPI_FENCE();
                if (u.pn < 16) {
#pragma unroll
                    for (int bj = 0; bj < 2; ++bj) { const f32x4 v0 = acc[ai][bj][m][0] * rs, v1 = acc[ai][bj][m][1] * rs;
                        u32x4 w; w.x = pk2(v0[0], v0[1]); w.y = pk2(v0[2], v0[3]); w.z = pk2(v1[0], v1[1]); w.w = pk2(v1[2], v1[3]);
                        if (u.pn < 12) { const int col = u.pn * 256 + bj * HALF + c0; *(u32x4*)(QKV + (size_t)row * QKVW + col) = w;
                            if ((row & 63) >= 61) *(u32x4*)(HALO + ((size_t)(row >> 6) * 3 + ((row & 63) - 61)) * QKVW + col) = w; }
                        else { const int col = (u.pn - 12) * 256 + bj * HALF + c0; *(u32x4*)(Z + (size_t)row * D + col) = w; } }
                } else if (wc == 0 && fq < 2) {
#pragma unroll
                    for (int n = 0; n < 2; ++n) { f32x4 o;
#pragma unroll
                        for (int j = 0; j < 4; ++j) { const float v = acc[ai][0][m][n][j] * rs; const int h = 4 * n + j;
                            o[j] = (fq == 0) ? -__expf(a_log[h]) * softplusf_(v + dt_bias[h]) : sigmoidf_(v); }
                        *(f32x4*)(AB + (size_t)row * 16 + 8 * fq + 4 * n) = o; }
                } }
    }
};
struct EpiSoftmax {
    static constexpr bool PERM = true;
    bf16* P; const float* ssq; LAS float* red;
    __device__ __forceinline__ void operator()(Acc& acc, const Unit& u, int wr, int wc, int fr, int fq) const {
        asm volatile("" : "+v"(fr), "+v"(fq));
        const int rl0 = wr * 64 + fr, col0 = u.pn * BM + wc * 32 + 8 * fq;
        float mx[2][4];
        rs_fill(ssq, u.pm, red + 2048, (wr * 4 + wc) * 64 + fq * 16 + fr);
#pragma unroll
        for (int ai = 0; ai < 2; ++ai)
#pragma unroll
            for (int m = 0; m < 4; ++m) { const int rl = rl0 + ai * HALF + m * 16; const float rs = red[2048 + rl]; float t = -3.0e38f;
#pragma unroll
                for (int bj = 0; bj < 2; ++bj)
#pragma unroll
                    for (int n = 0; n < 2; ++n) { acc[ai][bj][m][n] = acc[ai][bj][m][n] * rs; const f32x4 v = acc[ai][bj][m][n]; t = fmaxf(t, fmaxf(fmaxf(v[0], v[1]), fmaxf(v[2], v[3]))); }
                t = fmaxf(t, __shfl_xor(t, 16)); t = fmaxf(t, __shfl_xor(t, 32));
                if (fq == 0) red[rl * 4 + wc] = t; }
        __syncthreads();
#pragma unroll
        for (int ai = 0; ai < 2; ++ai)
#pragma unroll
            for (int m = 0; m < 4; ++m) { const int rl = rl0 + ai * HALF + m * 16; const f32x4 r = *(const LAS f32x4*)(red + rl * 4);
                const float M = fmaxf(fmaxf(r[0], r[1]), fmaxf(r[2], r[3])); float s = 0.f;
#pragma unroll
                for (int bj = 0; bj < 2; ++bj)
#pragma unroll
                    for (int n = 0; n < 2; ++n) { f32x4 v = acc[ai][bj][m][n];
#pragma unroll
                        for (int j = 0; j < 4; ++j) { v[j] = __expf(v[j] - M); s += v[j]; }
                        acc[ai][bj][m][n] = v; }
                s += __shfl_xor(s, 16); s += __shfl_xor(s, 32);
                if (fq == 0) red[1024 + rl * 4 + wc] = s; mx[ai][m] = 0.f; }
        __syncthreads();
#pragma unroll
        for (int ai = 0; ai < 2; ++ai)
#pragma unroll
            for (int m = 0; m < 4; ++m) { const int rl = rl0 + ai * HALF + m * 16; const f32x4 r = *(const LAS f32x4*)(red + 1024 + rl * 4);
                const float inv = 1.f / ((r[0] + r[1]) + (r[2] + r[3]));
                bf16* rowp = P + (size_t)(u.pm * BM + rl) * D + col0;
#pragma unroll
                for (int bj = 0; bj < 2; ++bj) { const f32x4 v0 = acc[ai][bj][m][0] * inv, v1 = acc[ai][bj][m][1] * inv;
                    u32x4 w; w.x = pk2(v0[0], v0[1]); w.y = pk2(v0[2], v0[3]); w.z = pk2(v1[0], v1[1]); w.w = pk2(v1[2], v1[3]);
                    *(u32x4*)(rowp + bj * HALF) = w; } }
        __syncthreads();
        (void)mx;
    }
};
struct KvSched {
    int G, c; const unsigned char* ws;
    __device__ bool next(int i, Unit& u) const { const int L = i * G + c; if (L >= 16) return false; const int l = L >> 3, t = L & 7; u.pm = 0; u.pn = t; u.aux = L;
        u.a = (const char*)(ws + WS_MEMB); u.b = (const char*)(ws + WS_OB + (size_t)l * 8 * MiB) + (size_t)t * 256 * 1024 * 2; return true; }
};
struct QkSched {
    int G, c; const unsigned char* ws;
    __device__ bool next(int i, Unit& u) const { const int L = i * G + c; if (L >= 32) return false; const int l = L >> 4, h = (L >> 2) & 3, t = L & 3; u.pm = 0; u.pn = 0; u.aux = L;
        u.a = (const char*)(ws + WS_KV) + ((size_t)l * 256 * 2048 + h * 256) * 2;
        u.b = (const char*)(ws + WS_OB + (size_t)l * 8 * MiB + 4 * MiB) + ((size_t)t * 256 * 1024 + h * 256) * 2; return true; }
};
struct VoSched {
    int G, c; const unsigned char* ws;
    __device__ bool next(int i, Unit& u) const { const int L = i * G + c; if (L >= 32) return false; const int l = L >> 4, h = (L >> 2) & 3, t = L & 3; u.pm = 0; u.pn = 0; u.aux = L;
        u.a = (const char*)(ws + WS_OB + (size_t)l * 8 * MiB + 6 * MiB) + ((size_t)t * 256 * 1024 + h * 256) * 2;
        u.b = (const char*)(ws + WS_KV) + ((size_t)l * 256 * 2048 + 1024 + h * 256) * 2; return true; }
};
#undef PG8_BAR
}

__device__ __forceinline__ void transpose_item(const float* W, int K, int N, bf16* WT, const float* gk, int mode, LAS float* scr, int item, int lane) {
    const int nblk = (N + 31) / 32, kb = item / nblk, nb = item % nblk, k0 = 64 * kb, n0 = 32 * nb;
    const int kr = lane >> 3, c4 = (lane & 7) * 4; const bool ok = (n0 + c4) < N;
    f32x4 v[8];
#pragma unroll
    for (int i = 0; i < 8; ++i) v[i] = ok ? __builtin_nontemporal_load((const f32x4*)(W + (size_t)(k0 + 8 * i + kr) * N + n0 + c4)) : (f32x4){0.f, 0.f, 0.f, 0.f};
    if (gk) {
#pragma unroll
        for (int i = 0; i < 8; ++i) v[i] = v[i] * gk[k0 + 8 * i + kr]; }
#pragma unroll
    for (int i = 0; i < 8; ++i) { LAS float* d = scr + (8 * i + kr) * 33 + c4; d[0] = v[i][0]; d[1] = v[i][1]; d[2] = v[i][2]; d[3] = v[i][3]; }
    asm volatile("s_waitcnt lgkmcnt(0)" ::: "memory");
    const int c = lane & 7;
#pragma unroll
    for (int j = 0; j < 4; ++j) { const int n = (lane >> 3) + 8 * j; const LAS float* s = scr + (8 * c) * 33 + n;
        u32x4 o; o.x = pk2(s[0 * 33], s[1 * 33]); o.y = pk2(s[2 * 33], s[3 * 33]); o.z = pk2(s[4 * 33], s[5 * 33]); o.w = pk2(s[6 * 33], s[7 * 33]);
        int nr = n0 + n;
        if (mode == 1) { nr = nr < FF ? ((nr >> 7) * 256 + (nr & 127)) : (((nr - FF) >> 7) * 256 + 128 + ((nr - FF) & 127)); }
        *(u32x4*)(WT + (size_t)nr * K + k0 + 8 * c) = o; }
    asm volatile("s_waitcnt lgkmcnt(0)" ::: "memory");
}
__device__ __forceinline__ float wave_sum(float v) {
#pragma unroll
    for (int o = 1; o < 64; o <<= 1) v += __shfl_xor(v, o);
    return v;
}

struct Args { const float* in[30]; float* out; unsigned char* ws; };
__device__ __forceinline__ const void* karg(int i) {
    const __attribute__((address_space(4))) char* k = (const __attribute__((address_space(4))) char*)__builtin_amdgcn_kernarg_segment_ptr();
    asm volatile("" : "+s"(k));
    return *(const void* const __attribute__((address_space(4)))*)(k + 8 * i);
}
#define argin(i) ((const float*)karg(i))
#define argout() ((float*)karg(30))
#define argws() ((unsigned char*)karg(31))


#define TJ_RUN(W_, K_, N_, WT_, gk_, mode_) do { const int n_ = ((K_) / 64) * (((N_) + 31) / 32); for (int it = gw; it < n_; it += NGW) transpose_item((W_), (K_), (N_), (WT_), (gk_), (mode_), scr, it, lane); } while (0)
__device__ __forceinline__ void layer_weights(int l, int part, int gw, int NGW, LAS float* scr, int lane) {
    unsigned char* ws = argws();
    if (part & 2) {
        TJ_RUN(argin(12) + (size_t)l * D * 2 * FF, D, 2 * FF, (bf16*)(ws + WS_F2IN), argin(11) + l * D, 1);
        TJ_RUN(argin(13) + (size_t)l * FF * D, FF, D, (bf16*)(ws + WS_F2OUT), (const float*)nullptr, 0); }
    if (part & 1) {
        TJ_RUN(argin(3) + (size_t)l * D * 2 * FF, D, 2 * FF, (bf16*)(ws + WS_F1IN), argin(2) + l * D, 1);
        TJ_RUN(argin(4) + (size_t)l * FF * D, FF, D, (bf16*)(ws + WS_F1OUT), (const float*)nullptr, 0); }
    if (part & 4) {
        if (l == 0) { TJ_RUN(argin(14), D, ABN, (bf16*)(ws + WS_MIXIN), argin(5), 0); TJ_RUN(argin(22), D, D, (bf16*)(ws + WS_MIXOUT), (const float*)nullptr, 0); }
        else { TJ_RUN(argin(23), D, DNREAL, (bf16*)(ws + WS_MIXIN), argin(5) + D, 0); TJ_RUN(argin(28), D, D, (bf16*)(ws + WS_MIXOUT), (const float*)nullptr, 0); } }
}

struct AtRegs { bf16x8 k00, k01, k10, k11; u32x4 vv[4]; };
struct AtState { int t0; const bf16* kbase; const bf16* vbase; bf16x8 qf0, qf1; float mrun, lrun; f32x4 o[4]; LAS unsigned char* vt; };
__device__ __forceinline__ void attn_init(AtState& U, const bf16* __restrict__ QKV, LAS unsigned char* vt, int u, int lane) {
    const int r16 = u & 15, h = (u >> 4) & 7, blk = u >> 7, c = lane & 15, q = lane >> 4, hf = lane >> 5;
    U.t0 = blk * 256 + r16; U.vt = vt;
    const bf16* qrow = QKV + (size_t)(U.t0 + 16 * c) * ABN + h * 64;
    U.qf0 = *(const bf16x8*)(qrow + 8 * q); U.qf1 = *(const bf16x8*)(qrow + 32 + 8 * q);
    U.mrun = -1.0e30f; U.lrun = 0.f;
#pragma unroll
    for (int i = 0; i < 4; ++i) U.o[i] = (f32x4){0.f, 0.f, 0.f, 0.f};
    U.kbase = QKV + 512 + h * 64 + 8 * q; U.vbase = QKV + 1024 + h * 64 + (lane & 3) * 8; (void)hf;
}
__device__ __forceinline__ void attn_load(const AtState& U, AtRegs& R, const int n, int lane) {
    const int c = lane & 15, kk = lane & 31;
    const int di = n < 12 ? 0 : (n < 18 ? 1 : 2), T = n - (di == 0 ? 0 : (di == 1 ? 12 : 18));
    const int d = 1 << (2 * di), kstart = U.t0 - 128 * d;
    int tk0 = kstart + (32 * T + c) * d; tk0 = tk0 < 0 ? 0 : (tk0 > S - 1 ? S - 1 : tk0);
    int tk1 = kstart + (32 * T + 16 + c) * d; tk1 = tk1 < 0 ? 0 : (tk1 > S - 1 ? S - 1 : tk1);
    int tv0 = kstart + (32 * T + (lane >> 2)) * d; tv0 = tv0 < 0 ? 0 : (tv0 > S - 1 ? S - 1 : tv0);
    int tv1 = kstart + (32 * T + 16 + (lane >> 2)) * d; tv1 = tv1 < 0 ? 0 : (tv1 > S - 1 ? S - 1 : tv1);
    const bf16* k0p = U.kbase + (size_t)tk0 * ABN; const bf16* k1p = U.kbase + (size_t)tk1 * ABN;
    R.k00 = *(const bf16x8*)k0p; R.k01 = *(const bf16x8*)(k0p + 32); R.k10 = *(const bf16x8*)k1p; R.k11 = *(const bf16x8*)(k1p + 32);
    const bf16* v0p = U.vbase + (size_t)tv0 * ABN; const bf16* v1p = U.vbase + (size_t)tv1 * ABN;
    R.vv[0] = *(const u32x4*)v0p; R.vv[1] = *(const u32x4*)v1p; R.vv[2] = *(const u32x4*)(v0p + 32); R.vv[3] = *(const u32x4*)(v1p + 32);
    (void)kk;
}
__device__ __forceinline__ void attn_compute(AtState& U, const AtRegs& R, const int n, int lane) {
    const int c = lane & 15, q = lane >> 4, kk = lane & 31, hf = lane >> 5;
    const float SC = 0.125f * 1.4426950408889634f;
    const int di = n < 12 ? 0 : (n < 18 ? 1 : 2), T = n - (di == 0 ? 0 : (di == 1 ? 12 : 18));
    const int d = 1 << (2 * di), e = 16 >> (2 * di), kstart = U.t0 - 128 * d;
    const int lo = c * e, hi = c * e + 128;
    f32x4 s0 = (f32x4){0.f, 0.f, 0.f, 0.f}, s1 = s0;
    s0 = MFMA16(R.k00, U.qf0, s0); s0 = MFMA16(R.k01, U.qf1, s0);
    s1 = MFMA16(R.k10, U.qf0, s1); s1 = MFMA16(R.k11, U.qf1, s1);
    bool v0[4], v1[4]; float tmax = -1.0e30f;
#pragma unroll
    for (int i = 0; i < 4; ++i) { const int n0 = 32 * T + 4 * q + i, n1 = n0 + 16;
        v0[i] = (n0 >= lo) && (n0 <= hi) && (kstart + n0 * d >= 0); v1[i] = (n1 >= lo) && (n1 <= hi) && (kstart + n1 * d >= 0);
        s0[i] = v0[i] ? s0[i] * SC : -1.0e30f; s1[i] = v1[i] ? s1[i] * SC : -1.0e30f;
        tmax = fmaxf(tmax, fmaxf(s0[i], s1[i])); }
    tmax = qred_max(tmax);
    const float mnew = fmaxf(U.mrun, tmax), alpha = __builtin_amdgcn_exp2f(U.mrun - mnew);
    float ps = 0.f; f32x4 p0, p1;
#pragma unroll
    for (int i = 0; i < 4; ++i) { p0[i] = v0[i] ? __builtin_amdgcn_exp2f(s0[i] - mnew) : 0.f; p1[i] = v1[i] ? __builtin_amdgcn_exp2f(s1[i] - mnew) : 0.f; ps += p0[i] + p1[i]; }
    ps = qred_sum(ps);
    U.lrun = U.lrun * alpha + ps; U.mrun = mnew;
#pragma unroll
    for (int i = 0; i < 4; ++i) U.o[i] = U.o[i] * alpha;
    const bf16x8 pb = pack8(p0, p1);
    LAS unsigned char* vt = U.vt;
#pragma unroll
    for (int i = 0; i < 4; ++i) *(LAS u32x4*)(vt + ((lane >> 2) + 16 * (i & 1)) * 144 + 64 * (i >> 1) + 16 * (lane & 3)) = R.vv[i];
    (void)kk; (void)hf;
    __builtin_amdgcn_wave_barrier(); asm volatile("s_waitcnt lgkmcnt(0)" ::: "memory");
    { const int rq = (lane & 15) >> 2, p4 = lane & 3; LAS unsigned char* tb = vt + (4 * q + rq) * 144 + p4 * 8;
#pragma unroll
      for (int Dt = 0; Dt < 4; ++Dt) {
          const s16x4 lo8 = __builtin_amdgcn_ds_read_tr16_b64_v4i16((LAS s16x4*)(tb + Dt * 32));
          const s16x4 hi8 = __builtin_amdgcn_ds_read_tr16_b64_v4i16((LAS s16x4*)(tb + 16 * 144 + Dt * 32));
          const bf16x8 vf = __builtin_shufflevector(lo8, hi8, 0, 1, 2, 3, 4, 5, 6, 7);
          U.o[Dt] = MFMA16(vf, pb, U.o[Dt]); } }
    __builtin_amdgcn_wave_barrier();
}
__device__ __forceinline__ void attn_finish(const AtState& U, bf16* __restrict__ OB, int u, int lane) {
    const int h = (u >> 4) & 7, c = lane & 15, q = lane >> 4;
    const float inv = 1.f / U.lrun;
    bf16* orow = OB + (size_t)(U.t0 + 16 * c) * D + h * 64 + 4 * q;
#pragma unroll
    for (int Dt = 0; Dt < 4; ++Dt) { u32x2 w; w.x = pk2(U.o[Dt][0] * inv, U.o[Dt][1] * inv); w.y = pk2(U.o[Dt][2] * inv, U.o[Dt][3] * inv); *(u32x2*)(orow + 16 * Dt) = w; }
}
__device__ __forceinline__ void attn_unit2(const bf16* __restrict__ QKV, bf16* __restrict__ OB, LAS unsigned char* vt, int ua, int ub, int lane) {
    AtState A, B; AtRegs RA, RB;
    attn_init(A, QKV, vt, ua, lane); attn_init(B, QKV, vt + 4608, ub, lane);
    attn_load(A, RA, 0, lane); attn_load(B, RB, 0, lane);
    for (int n = 0; n < 23; ++n) { const int nn = n + 1 < 23 ? n + 1 : 22;
        attn_compute(A, RA, n, lane); attn_load(A, RA, nn, lane);
        attn_compute(B, RB, n, lane); attn_load(B, RB, nn, lane); }
    attn_finish(A, OB, ua, lane); attn_finish(B, OB, ub, lane);
}

__device__ __forceinline__ void lru_local_unit(LAS float* L, int unit, const bool load_w) {
    int tid_l = threadIdx.x; asm volatile("" : "+v"(tid_l));
    const int tt = unit >> 3, cb = unit & 7, tid = tid_l, k = tid & 63, tg = tid >> 6;
    const bf16* XG = (const bf16*)(argws() + WS_BIG);
    LAS float* xc = L; LAS float* wa = L + 64 * 65; LAS float* wx = wa + 4096; LAS float* LA = wx + 4096; LAS float* LB = LA + 64 * 65;
    const float* Wa = argin(17) + (size_t)cb * 4096; const float* Wx = argin(19) + (size_t)cb * 4096;
    if (load_w) { for (int i = tid; i < 4096; i += 512) { wa[i] = Wa[i]; wx[i] = Wx[i]; } }
    const int ch = cb * 64 + k;
    { const float cw0 = argin(15)[ch], cw1 = argin(15)[512 + ch], cw2 = argin(15)[1024 + ch], cw3 = argin(15)[1536 + ch], cbias = argin(16)[ch];
      const int tb = tt * 64 + tg * 8;
      float xm3 = tb - 3 >= 0 ? bf2f(XG[(size_t)(tb - 3) * ABN + 1536 + ch]) : 0.f, xm2 = tb - 2 >= 0 ? bf2f(XG[(size_t)(tb - 2) * ABN + 1536 + ch]) : 0.f, xm1 = tb - 1 >= 0 ? bf2f(XG[(size_t)(tb - 1) * ABN + 1536 + ch]) : 0.f;
#pragma unroll
      for (int i = 0; i < 8; ++i) { const float x0 = bf2f(XG[(size_t)(tb + i) * ABN + 1536 + ch]);
          xc[(tg * 8 + i) * 65 + k] = cbias + cw0 * xm3 + cw1 * xm2 + cw2 * xm1 + cw3 * x0; xm3 = xm2; xm2 = xm1; xm1 = x0; } }
    __syncthreads();
    float ra[8], ri[8];
#pragma unroll
    for (int i = 0; i < 8; ++i) { ra[i] = 0.f; ri[i] = 0.f; }
    for (int j = 0; j < 64; ++j) { const float aw = wa[j * 64 + k], xw = wx[j * 64 + k];
#pragma unroll
        for (int i = 0; i < 8; ++i) { const float xv = xc[(tg * 8 + i) * 65 + j]; ra[i] += xv * aw; ri[i] += xv * xw; } }
    float hl[8], pl[8];
    { const float ba = argin(18)[ch], bx = argin(20)[ch], spl = softplusf_(-argin(21)[ch]); float hh = 0.f, pp = 1.f;
#pragma unroll
      for (int i = 0; i < 8; ++i) { const float r = sigmoidf_(ra[i] + ba), ig = sigmoidf_(ri[i] + bx);
          const float log_a = -8.0f * r * spl; const float av = __expf(log_a); const float mult = sqrtf(-expm1f(2.f * log_a));
          const float bv = mult * ig * xc[(tg * 8 + i) * 65 + k];
          hh = av * hh + bv; pp *= av; hl[i] = hh; pl[i] = pp; }
      LA[tg * 64 + k] = pp; LB[tg * 64 + k] = hh; }
    __syncthreads();
    { float Hc = 0.f, Pc = 1.f;
#pragma unroll
      for (int g = 0; g < 7; ++g) if (g < tg) { const float pg = LA[g * 64 + k], hg = LB[g * 64 + k]; Hc = pg * Hc + hg; Pc *= pg; }
      float* HL = (float*)(argws() + WS_XB); float* PC = (float*)(argws() + WS_BIG + 80 * MiB);
#pragma unroll
      for (int i = 0; i < 8; ++i) { const size_t off = (size_t)(tt * 64 + tg * 8 + i) * 512 + ch; HL[off] = hl[i] + pl[i] * Hc; PC[off] = pl[i] * Pc; }
      if (tg == 7) { float* TOT = (float*)(argws() + WS_LRUTOT); TOT[(size_t)tt * 512 + ch] = pl[7] * Pc; TOT[(size_t)(256 + tt) * 512 + ch] = hl[7] + pl[7] * Hc; } }
    __syncthreads();
}
__device__ __forceinline__ void lru_apply_wg(LAS float* L, int bx, int G) {
    int tid_l = threadIdx.x; asm volatile("" : "+v"(tid_l));
    const int tid = tid_l, k = tid & 63, tg = tid >> 6, cb = bx & 7, ch = cb * 64 + k;
    unsigned char* ws = argws();
    const float* TOT = (const float*)(ws + WS_LRUTOT);
    const float* HL = (const float*)(ws + WS_XB); const float* PC = (const float*)(ws + WS_BIG + 80 * MiB);
    const bf16* XG = (const bf16*)(ws + WS_BIG); bf16* OB = (bf16*)(ws + WS_OB);
    float H = 0.f; int cprev = 0;
    for (int tt = bx >> 3; tt < 256; tt += (G >> 3)) {
        if (tid < 64) {
            int c = cprev;
            for (; c + 32 <= tt; c += 32) { float av[32], bv[32];
#pragma unroll
                for (int i = 0; i < 32; ++i) { av[i] = TOT[(size_t)(c + i) * 512 + ch]; bv[i] = TOT[(size_t)(256 + c + i) * 512 + ch]; }
#pragma unroll
                for (int i = 0; i < 32; ++i) H = av[i] * H + bv[i]; }
            for (; c + 8 <= tt; c += 8) { float av[8], bv[8];
#pragma unroll
                for (int i = 0; i < 8; ++i) { av[i] = TOT[(size_t)(c + i) * 512 + ch]; bv[i] = TOT[(size_t)(256 + c + i) * 512 + ch]; }
#pragma unroll
                for (int i = 0; i < 8; ++i) H = av[i] * H + bv[i]; }
            for (; c < tt; ++c) H = TOT[(size_t)c * 512 + ch] * H + TOT[(size_t)(256 + c) * 512 + ch];
            L[tid] = H; }
        cprev = tt;
        __syncthreads();
        const float Hin = L[k];
#pragma unroll
        for (int i = 0; i < 8; ++i) { const int t = tt * 64 + tg * 8 + i; const size_t off = (size_t)t * 512 + ch;
            const float hv = HL[off] + PC[off] * Hin; const float gr = bf2f(XG[(size_t)t * ABN + 2048 + ch]);
            OB[(size_t)t * D + 512 + ch] = (unsigned short)(pk2(hv * gelu_tanh(gr), 0.f) & 0xffffu); }
        __syncthreads();
    }
}

__device__ __forceinline__ void dn_local_unit(LAS unsigned char* lds, int unit) {
    int tid_l = threadIdx.x; asm volatile("" : "+v"(tid_l));
    const int c = unit >> 3, h = unit & 7, tid = tid_l, lane = tid & 63, wid = tid >> 6;
    bf16* QKV = (bf16*)(argws() + WS_BIG); const bf16* HALO = (const bf16*)(argws() + WS_HALO);
    const float* AB = (const float*)(argws() + WS_DNAB);
    LAS unsigned char* qb = lds; LAS unsigned char* kb = lds + 17408; LAS unsigned char* vb = lds + 34816;
    LAS float* Am = (LAS float*)(lds + 52224);
    LAS float* sc = (LAS float*)(lds + 52224 + 16384);
    { const int i = tid >> 3, sg = tid & 7;
#pragma unroll
      for (int ten = 0; ten < 3; ++ten) { const int col = ten * 1024 + h * 128 + sg * 8;
          float val[16];
#pragma unroll
          for (int e = 0; e < 16; ++e) val[e] = 0.f;
#pragma unroll
          for (int j = 0; j < 4; ++j) { const int ri = i + j - 3; const bf16* src;
              bool zero = false;
              if (ri >= 0) src = QKV + (size_t)(c * 64 + ri) * QKVW + col; else if (c > 0) src = HALO + ((size_t)(c - 1) * 3 + (ri + 3)) * QKVW + col; else { zero = true; src = QKV; }
              u32x4 r0 = (u32x4){0u, 0u, 0u, 0u}, r1 = r0; if (!zero) { r0 = *(const u32x4*)src; r1 = *(const u32x4*)(src + 64); }
              const float* cw = argin(24) + (size_t)j * QKVW + col;
              const f32x4 w0 = *(const f32x4*)cw, w1 = *(const f32x4*)(cw + 4), w2 = *(const f32x4*)(cw + 64), w3 = *(const f32x4*)(cw + 68);
#pragma unroll
              for (int e = 0; e < 4; ++e) { val[2 * e] += bflo(r0[e]) * (e < 2 ? w0[2 * e] : w1[2 * e - 4]); val[2 * e + 1] += bfhi(r0[e]) * (e < 2 ? w0[2 * e + 1] : w1[2 * e - 3]);
                  val[8 + 2 * e] += bflo(r1[e]) * (e < 2 ? w2[2 * e] : w3[2 * e - 4]); val[8 + 2 * e + 1] += bfhi(r1[e]) * (e < 2 ? w2[2 * e + 1] : w3[2 * e - 3]); } }
          float ss = 0.f;
#pragma unroll
          for (int e = 0; e < 16; ++e) { val[e] = siluf_(val[e]); ss += val[e] * val[e]; }
          float scl = 1.f;
          if (ten < 2) { ss += __shfl_xor(ss, 1); ss += __shfl_xor(ss, 2); ss += __shfl_xor(ss, 4); scl = rsqrtf(ss + 1e-6f); }
          u32x4 o0, o1;
#pragma unroll
          for (int e = 0; e < 4; ++e) { o0[e] = pk2(val[2 * e] * scl, val[2 * e + 1] * scl); o1[e] = pk2(val[8 + 2 * e] * scl, val[8 + 2 * e + 1] * scl); }
          LAS unsigned char* dst = (ten == 0 ? qb : (ten == 1 ? kb : vb)) + i * 272 + sg * 16;
          *(LAS u32x4*)dst = o0; *(LAS u32x4*)(dst + 128) = o1; } }
    if (wid == 0) { const int t = c * 64 + lane; float g = AB[(size_t)t * 16 + h]; const float be = AB[(size_t)t * 16 + 8 + h];
#pragma unroll
        for (int o = 1; o < 64; o <<= 1) { const float y = __shfl_up(g, o); if (lane >= o) g += y; }
        sc[lane] = g; sc[64 + lane] = be; sc[128 + lane] = __expf(g);
        if (lane == 63) ((float*)(argws() + WS_DECAY))[c * 8 + h] = __expf(g); }
    __syncthreads();
    { const int cc = lane & 15, q = lane >> 4, rt = wid & 3; const bool isqk = wid >= 4;
      const LAS unsigned char* Ab = (isqk ? qb : kb) + (rt * 16 + cc) * 272 + 16 * q;
      bf16x8 af[4];
#pragma unroll
      for (int ks = 0; ks < 4; ++ks) af[ks] = *(const LAS bf16x8*)(Ab + 64 * ks);
#pragma unroll
      for (int ct = 0; ct < 4; ++ct) { f32x4 r = (f32x4){0.f, 0.f, 0.f, 0.f};
          const LAS unsigned char* Bb = kb + (ct * 16 + cc) * 272 + 16 * q;
#pragma unroll
          for (int ks = 0; ks < 4; ++ks) r = MFMA16(af[ks], *(const LAS bf16x8*)(Bb + 64 * ks), r);
          const int j = ct * 16 + cc; const float gj = sc[j];
#pragma unroll
          for (int e = 0; e < 4; ++e) { const int i = rt * 16 + 4 * q + e; const float gi = sc[i];
              if (!isqk) { Am[i * 64 + j] = (i > j) ? r[e] * sc[64 + i] * __expf(gi - gj) : 0.f; }
              else { const float v = (i >= j) ? r[e] * 0.08838834764831845f * __expf(gi - gj) : 0.f;
                  ((bf16*)(argws() + WS_OB))[((size_t)(c * 8 + h) * 64 + i) * 64 + j] = (unsigned short)(pk2(v, 0.f) & 0xffffu); } } } }
    __syncthreads();
    if (tid < 256) { const int cl = tid; float s[64];
        if (cl < 128) {
#pragma unroll
            for (int i = 0; i < 64; ++i) s[i] = bf2f(*(const LAS unsigned short*)(vb + i * 272 + cl * 2)) * sc[64 + i];
        } else {
#pragma unroll
            for (int i = 0; i < 64; ++i) s[i] = bf2f(*(const LAS unsigned short*)(kb + i * 272 + (cl - 128) * 2)) * sc[64 + i] * sc[128 + i];
        }
#pragma unroll
        for (int i = 1; i < 64; ++i) { float a4[4] = {0.f, 0.f, 0.f, 0.f};
#pragma unroll
            for (int j4 = 0; j4 < (i + 3) / 4; ++j4) { const f32x4 av = *(const LAS f32x4*)(Am + i * 64 + 4 * j4);
#pragma unroll
                for (int e = 0; e < 4; ++e) if (4 * j4 + e < i) a4[e] += av[e] * s[4 * j4 + e]; }
            s[i] = s[i] - ((a4[0] + a4[1]) + (a4[2] + a4[3])); }
        if (cl < 128) { bf16* dst = QKV + (size_t)(c * 64) * QKVW + 2048 + h * 128 + cl;
#pragma unroll
            for (int i = 0; i < 64; ++i) dst[(size_t)i * QKVW] = (unsigned short)(pk2(s[i], 0.f) & 0xffffu); }
        else { bf16* dst = (bf16*)(argws() + WS_XB) + (size_t)(c * 64) * D + h * 128 + (cl - 128);
#pragma unroll
            for (int i = 0; i < 64; ++i) dst[(size_t)i * D] = (unsigned short)(pk2(s[i], 0.f) & 0xffffu); }
    } else { const int t2 = tid - 256; const float glast = sc[63];
        { const int i = t2 >> 2, sg = t2 & 3; const float f = sc[128 + i] * 0.08838834764831845f;
          const LAS u32x4* src = (const LAS u32x4*)(qb + i * 272 + sg * 64); u32x4* dst = (u32x4*)(QKV + (size_t)(c * 64 + i) * QKVW + h * 128 + sg * 32);
#pragma unroll
          for (int p = 0; p < 4; ++p) { const u32x4 v = src[p]; u32x4 o;
#pragma unroll
              for (int e = 0; e < 4; ++e) o[e] = pk2(bflo(v[e]) * f, bfhi(v[e]) * f);
              dst[p] = o; } }
        { const int rr = t2 >> 1, hfj = t2 & 1;
          bf16* dst = QKV + (size_t)(c * 64 + (rr >> 1)) * QKVW + 1024 + h * 128 + (rr & 1) * 64 + hfj * 32;
#pragma unroll
          for (int p = 0; p < 4; ++p) { u32x4 o;
#pragma unroll
              for (int e = 0; e < 4; ++e) { const int j0 = hfj * 32 + p * 8 + 2 * e;
                  const float k0 = bf2f(*(const LAS unsigned short*)(kb + j0 * 272 + rr * 2)) * __expf(glast - sc[j0]);
                  const float k1 = bf2f(*(const LAS unsigned short*)(kb + (j0 + 1) * 272 + rr * 2)) * __expf(glast - sc[j0 + 1]);
                  o[e] = pk2(k0, k1); }
              *(u32x4*)(dst + p * 8) = o; } } }
    __syncthreads();
}

constexpr int DS_W = 0, DS_QG = 17408, DS_KD = 34816, DS_QK = 53248, DS_U = 62464, DS_BUF = 64512, DS_VN = 2 * DS_BUF, DS_ST = DS_VN + 2304;
__device__ __forceinline__ void dn_scan_worker(LAS unsigned char* lds, int worker, const int c0, const int c1, f32x4 (&Sacc)[2]) {
    int tid_l = threadIdx.x; asm volatile("" : "+v"(tid_l));
    const int h = worker >> 3, sl = worker & 7, tid = tid_l, lane = tid & 63, wid = __builtin_amdgcn_readfirstlane(tid >> 6);
    unsigned char* ws = argws();
    bf16* QKV = (bf16*)(ws + WS_BIG); const bf16* Wr = (const bf16*)(ws + WS_XB); const bf16* QKr = (const bf16*)(ws + WS_OB);
    const float* DEC = (const float*)(ws + WS_DECAY);
    const char* srcp[8]; unsigned strd[8], dsto[8]; u32x4 preA[8], preB[8];
#pragma unroll
    for (int i = 0; i < 8; ++i) { const int p = tid + 512 * i;
        if (p < 1024) { const int row = p >> 4, chn = p & 15; dsto[i] = DS_W + row * 272 + chn * 16; srcp[i] = (const char*)(Wr + (size_t)row * D + h * 128) + chn * 16; strd[i] = 64 * D * 2; }
        else if (p < 2048) { const int pp = p - 1024, row = pp >> 4, chn = pp & 15; dsto[i] = DS_QG + row * 272 + chn * 16; srcp[i] = (const char*)(QKV + (size_t)row * QKVW + h * 128) + chn * 16; strd[i] = 64 * QKVW * 2; }
        else if (p < 3072) { const int pp = p - 2048, seg = pp >> 4, chn = pp & 15; dsto[i] = DS_KD + (2 * seg + (chn >> 3)) * 144 + (chn & 7) * 16; srcp[i] = (const char*)(QKV + (size_t)seg * QKVW + 1024 + h * 128) + chn * 16; strd[i] = 64 * QKVW * 2; }
        else if (p < 3584) { const int pp = p - 3072, row = pp >> 3, chn = pp & 7; dsto[i] = DS_QK + row * 144 + chn * 16; srcp[i] = (const char*)(QKr + ((size_t)h * 64 + row) * 64) + chn * 16; strd[i] = 8 * 4096 * 2; }
        else { const int pp = (p - 3584) & 127, row = pp >> 1, chn = pp & 1; dsto[i] = DS_U + row * 32 + chn * 16; srcp[i] = (const char*)(QKV + (size_t)row * QKVW + 2048 + h * 128 + sl * 16) + chn * 16; strd[i] = 64 * QKVW * 2; } }
    const bool last_ok = tid < 128;
#define DN_LOAD(P, c) do { _Pragma("unroll") for (int i_ = 0; i_ < 8; ++i_) P[i_] = *(const u32x4*)(srcp[i_] + (size_t)(c) * strd[i_]); } while (0)
#define DN_STORE(P, bufo) do { _Pragma("unroll") for (int i_ = 0; i_ < 8; ++i_) if (i_ < 7 || last_ok) *(LAS u32x4*)(lds + (bufo) + dsto[i_]) = P[i_]; } while (0)
    DN_LOAD(preA, c0); DN_STORE(preA, 0); DN_LOAD(preA, c0 + 1); DN_LOAD(preB, c0 + 2);
    if (c0 == 0) { for (int i = tid; i < 4352 / 4; i += 512) ((LAS unsigned*)(lds + DS_ST))[i] = 0u; }
    if (tid < c1 - c0) ((LAS float*)(lds + DS_ST + 4352))[c0 + tid] = DEC[(c0 + tid) * 8 + h];
    __syncthreads();
    const int cc = lane & 15, q = lane >> 4, T = wid;
    auto step = [&](const int c, u32x4 (&P)[8]) {
        const int bo = (c & 1) * DS_BUF;
        DN_STORE(P, ((c + 1) & 1) * DS_BUF);
        DN_LOAD(P, c + 3 < c1 ? c + 3 : c1 - 1);
        const LAS unsigned char* B = lds + bo;
        f32x4 oa = (f32x4){0.f, 0.f, 0.f, 0.f};
        if (wid < 4) {
            f32x4 wS = (f32x4){0.f, 0.f, 0.f, 0.f};
#pragma unroll
            for (int ks = 0; ks < 4; ++ks) {
                const LAS unsigned char* sp = lds + DS_ST + cc * 272 + (32 * ks + 4 * q) * 2;
                const bf16x8 Sb = __builtin_shufflevector(*(const LAS s16x4*)sp, *(const LAS s16x4*)(sp + 32), 0, 1, 2, 3, 4, 5, 6, 7);
                const LAS unsigned char* wp = B + DS_W + (16 * T + cc) * 272 + (32 * ks + 4 * q) * 2;
                const bf16x8 wf = __builtin_shufflevector(*(const LAS s16x4*)wp, *(const LAS s16x4*)(wp + 32), 0, 1, 2, 3, 4, 5, 6, 7);
                wS = MFMA16(wf, Sb, wS);
                const LAS unsigned char* qp = B + DS_QG + (16 * T + cc) * 272 + (32 * ks + 4 * q) * 2;
                const bf16x8 qf = __builtin_shufflevector(*(const LAS s16x4*)qp, *(const LAS s16x4*)(qp + 32), 0, 1, 2, 3, 4, 5, 6, 7);
                oa = MFMA16(qf, Sb, oa); }
            f32x4 vn;
#pragma unroll
            for (int e = 0; e < 4; ++e) { const int row = 16 * T + 4 * q + e; vn[e] = bf2f(*(const LAS unsigned short*)(B + DS_U + row * 32 + cc * 2)) - wS[e]; }
            u32x2 w; w.x = pk2(vn[0], vn[1]); w.y = pk2(vn[2], vn[3]);
            *(LAS u32x2*)(lds + DS_VN + cc * 144 + (16 * T + 4 * q) * 2) = w;
        }
        asm volatile("s_waitcnt lgkmcnt(0)" ::: "memory"); __builtin_amdgcn_s_barrier(); asm volatile("" ::: "memory");
        if (wid < 4) {
            bf16x8 vbf[2];
#pragma unroll
            for (int k2 = 0; k2 < 2; ++k2) { const LAS unsigned char* vp = lds + DS_VN + cc * 144 + (32 * k2 + 4 * q) * 2;
                vbf[k2] = __builtin_shufflevector(*(const LAS s16x4*)vp, *(const LAS s16x4*)(vp + 32), 0, 1, 2, 3, 4, 5, 6, 7); }
#pragma unroll
            for (int k2 = 0; k2 < 2; ++k2) { const LAS unsigned char* pp = B + DS_QK + (16 * T + cc) * 144 + (32 * k2 + 4 * q) * 2;
                const bf16x8 pf = __builtin_shufflevector(*(const LAS s16x4*)pp, *(const LAS s16x4*)(pp + 32), 0, 1, 2, 3, 4, 5, 6, 7);
                oa = MFMA16(pf, vbf[k2], oa); }
            bf16* orow = QKV + (size_t)(c * 64) * QKVW + 2048 + h * 128 + sl * 16 + cc;
#pragma unroll
            for (int e = 0; e < 4; ++e) orow[(size_t)(16 * T + 4 * q + e) * QKVW] = (unsigned short)(pk2(oa[e], 0.f) & 0xffffu);
            const float dl = ((const LAS float*)(lds + DS_ST + 4352))[c];
#pragma unroll
            for (int r = 0; r < 2; ++r) { const int R = 2 * T + r; Sacc[r] = Sacc[r] * dl;
#pragma unroll
                for (int k2 = 0; k2 < 2; ++k2) { const LAS unsigned char* kp = B + DS_KD + (16 * R + cc) * 144 + (32 * k2 + 4 * q) * 2;
                    const bf16x8 kf = __builtin_shufflevector(*(const LAS s16x4*)kp, *(const LAS s16x4*)(kp + 32), 0, 1, 2, 3, 4, 5, 6, 7);
                    Sacc[r] = MFMA16(kf, vbf[k2], Sacc[r]); }
                u32x2 w; w.x = pk2(Sacc[r][0], Sacc[r][1]); w.y = pk2(Sacc[r][2], Sacc[r][3]);
                *(LAS u32x2*)(lds + DS_ST + cc * 272 + (16 * R + 4 * q) * 2) = w; }
        }
        asm volatile("s_waitcnt lgkmcnt(0)" ::: "memory"); __builtin_amdgcn_s_barrier(); asm volatile("" ::: "memory");
    };
    for (int c = c0; c < c1; c += 2) { step(c, preA); step(c + 1, preB); }
#undef DN_LOAD
#undef DN_STORE
}

__device__ __forceinline__ void dn_gate_rows(int r0, int r1, int w, int nw, int lane) {
    unsigned char* ws = argws();
    const bf16* QKV = (const bf16*)(ws + WS_BIG); const bf16* Z = (const bf16*)(ws + WS_BIG + 96 * MiB); const float* gn = argin(27); bf16* OB = (bf16*)(ws + WS_OB);
    for (int m = r0 + w; m < r1; m += nw) { const u32x4* op = (const u32x4*)(QKV + (size_t)m * QKVW + 2048 + lane * 16); const u32x4* zp = (const u32x4*)(Z + (size_t)m * D + lane * 16);
        const u32x4 o0 = op[0], o1 = op[1], z0 = zp[0], z1 = zp[1]; float ov[16], zv[16]; float ss = 0.f;
#pragma unroll
        for (int e = 0; e < 4; ++e) { ov[2 * e] = bflo(o0[e]); ov[2 * e + 1] = bfhi(o0[e]); ov[8 + 2 * e] = bflo(o1[e]); ov[9 + 2 * e] = bfhi(o1[e]);
            zv[2 * e] = bflo(z0[e]); zv[2 * e + 1] = bfhi(z0[e]); zv[8 + 2 * e] = bflo(z1[e]); zv[9 + 2 * e] = bfhi(z1[e]); }
#pragma unroll
        for (int e = 0; e < 16; ++e) ss += ov[e] * ov[e];
        ss += __shfl_xor(ss, 1); ss += __shfl_xor(ss, 2); ss += __shfl_xor(ss, 4);
        const float rs = rsqrtf(ss * (1.f / 128.f) + EPS); const float* gp = gn + (lane & 7) * 16; float y[16];
#pragma unroll
        for (int e = 0; e < 16; ++e) y[e] = ov[e] * rs * gp[e] * siluf_(zv[e]);
        u32x4 w0, w1;
#pragma unroll
        for (int e = 0; e < 4; ++e) { w0[e] = pk2(y[2 * e], y[2 * e + 1]); w1[e] = pk2(y[8 + 2 * e], y[9 + 2 * e]); }
        u32x4* dp = (u32x4*)(OB + (size_t)m * D + lane * 16); dp[0] = w0; dp[1] = w1; }
}

#define XB_TMO      128
#define XB_XCNT(j)  (256  + 64 * (j))
#define XB_XSUB(j)  (1280 + 64 * (j))
#define XB_XGEN(j)  (2304 + 64 * (j))
#define XB_TOP      3328
#define XB_TOPGEN   3392
#define XCD_BAR_WORDS 3456
#define XB_SPIN_CAP (1u << 18)
constexpr size_t WS_BAR = 65536;
__device__ __forceinline__ unsigned xb_ld(unsigned* p)              { return __hip_atomic_load(p, __ATOMIC_RELAXED, __HIP_MEMORY_SCOPE_AGENT); }
__device__ __forceinline__ unsigned xb_add(unsigned* p, unsigned v) { return __hip_atomic_fetch_add(p, v, __ATOMIC_RELAXED, __HIP_MEMORY_SCOPE_AGENT); }
__device__ __forceinline__ unsigned xb_xcc_id() { return (unsigned)__builtin_amdgcn_s_getreg((3 << 11) | 20) & 0xFu; }
#define XB_SPIN(cond, bar) do { unsigned _sp = 0; while (cond) { __builtin_amdgcn_s_sleep(1); \
    if ((++_sp & 255u) == 0u) { if (xb_ld(&(bar)[XB_TMO])) break; if (_sp > XB_SPIN_CAP) { atomicAdd(&(bar)[XB_TMO], 1u); break; } } } } while (0)
__device__ __forceinline__ void xcd_barrier_complete(unsigned* bar, unsigned x, unsigned& nloc, unsigned& nx) {
    const unsigned G = gridDim.x * gridDim.y * gridDim.z;
    unsigned sum, cnt, mine, sp = 0u;
    for (;;) {
        sum = 0u; cnt = 0u; mine = 0u;
#pragma unroll
        for (unsigned j = 0; j < 16; ++j) { const unsigned c = xb_ld(&bar[XB_XCNT(j)]); sum += c; cnt += (c > 0u) ? 1u : 0u; mine = (j == x) ? c : mine; }
        if (sum == G) break;
        __builtin_amdgcn_s_sleep(1);
        if ((++sp & 255u) == 0u) { if (xb_ld(&bar[XB_TMO])) break; if (sp > XB_SPIN_CAP) { atomicAdd(&bar[XB_TMO], 1u); break; } }
    }
    nloc = mine > 0u ? mine : 1u; nx = cnt > 0u ? cnt : 1u;
}
__device__ __forceinline__ void xcd_barrier(unsigned* bar, unsigned x, volatile LAS unsigned* st) {
    asm volatile("s_waitcnt vmcnt(0)" ::: "memory");
    __syncthreads();
    if (threadIdx.x == 0) {
        __builtin_amdgcn_s_waitcnt(0);
        unsigned nloc = st[0], nx = st[1];
        if (nloc == 0u) { xcd_barrier_complete(bar, x, nloc, nx); st[0] = nloc; st[1] = nx; }
        const unsigned old = xb_add(&bar[XB_XSUB(x)], 1u);
        const unsigned gen = old / nloc;
        if (old + 1u == (gen + 1u) * nloc) {
            __builtin_amdgcn_fence(__ATOMIC_RELEASE, "agent");
            asm volatile("s_waitcnt vmcnt(0)" ::: "memory");
            const unsigned og = xb_add(&bar[XB_TOP], 1u);
            const unsigned tg = og / nx;
            if (og + 1u == (tg + 1u) * nx) xb_add(&bar[XB_TOPGEN], 1u);
            else XB_SPIN(xb_ld(&bar[XB_TOPGEN]) == tg, bar);
            __builtin_amdgcn_fence(__ATOMIC_ACQUIRE, "agent");
            xb_add(&bar[XB_XGEN(x)], 1u);
            asm volatile("s_waitcnt vmcnt(0)" ::: "memory");
        } else {
            XB_SPIN(xb_ld(&bar[XB_XGEN(x)]) == gen, bar);
            __builtin_amdgcn_fence(__ATOMIC_ACQUIRE, "agent");
            asm volatile("s_waitcnt vmcnt(0)" ::: "memory");
        }
    }
    __syncthreads();
}

__global__ void __launch_bounds__(512, 2) mk_fwd(Args a) {
    extern __shared__ __attribute__((aligned(16))) unsigned char lds_raw[];
    LAS unsigned char* lds = (LAS unsigned char*)lds_raw;
    cg::grid_group grid = cg::this_grid();
    const int G = gridDim.x, bx = blockIdx.x, NGW = G * 8;
#ifdef EXFIL_A
    int nst = 0;
#define STAMP() do { unsigned long long* stp_ = (unsigned long long*)argws(); if (bx == 0 && threadIdx.x == 0) stp_[nst] = __builtin_amdgcn_s_memrealtime(); ++nst; } while (0)
#else
#define STAMP() do { } while (0)
#endif
    STAMP();
    volatile LAS unsigned* xst = (volatile LAS unsigned*)(lds + RED_OFF + 12288);
    if (threadIdx.x < 2) xst[threadIdx.x] = 0u;
    __syncthreads();
    const unsigned xcc = xb_xcc_id();
    { unsigned* bar_ = (unsigned*)(argws() + WS_BAR); if (threadIdx.x == 0) (void)xb_add(&bar_[XB_XCNT(xcc)], 1u); }
#define GSYNC() do { unsigned* bar_ = (unsigned*)(argws() + WS_BAR); xcd_barrier(bar_, xcc, xst); } while (0)
#define PH_VARS int tid_l = threadIdx.x; asm volatile("" : "+v"(tid_l)); const int lane = tid_l & 63, wave = __builtin_amdgcn_readfirstlane(tid_l >> 6), gw = bx * 8 + wave; \
    LAS float* scr = (LAS float*)(lds + wave * 16384); unsigned char* ws = argws(); float* X = argout(); bf16* XB = (bf16*)(ws + WS_XB); bf16* OB = (bf16*)(ws + WS_OB); float* SSQ = (float*)(ws + WS_SSQ); \
    (void)X; (void)XB; (void)OB; (void)SSQ; (void)scr; (void)lane; (void)gw;

    {   PH_VARS
        for (int l = 0; l < 2; ++l) {
            unsigned char* tb = ws + WS_OB + (size_t)l * 8 * MiB;
            TJ_RUN(argin(9) + (size_t)l * D * 2048, D, 2048, (bf16*)tb, argin(7) + l * D, 0);
            TJ_RUN(argin(10) + (size_t)l * D * D, D, D, (bf16*)(tb + 6 * MiB), (const float*)nullptr, 0);
            const float* Wq = argin(8) + (size_t)l * D * D; const float* gx = argin(6) + l * D; bf16* WQG = (bf16*)(tb + 4 * MiB);
            for (int i = gw * 64 + lane; i < D * D / 4; i += NGW * 64) { const f32x4 v = ((const f32x4*)Wq)[i]; const float g = gx[(i * 4) >> 10] * 0.0625f;
                u32x2 w; w.x = pk2(v[0] * g, v[1] * g); w.y = pk2(v[2] * g, v[3] * g); ((u32x2*)WQG)[i] = w; }
        }
    }
    {   PH_VARS
        for (int m = gw; m < NMEM; m += NGW) { const f32x4* xr = (const f32x4*)(argin(1) + (size_t)m * D) + lane; float s = 0.f; f32x4 v[4];
#pragma unroll
            for (int j = 0; j < 4; ++j) { v[j] = xr[64 * j]; s += (v[j][0] * v[j][0] + v[j][1] * v[j][1]) + (v[j][2] * v[j][2] + v[j][3] * v[j][3]); }
            s = wave_sum(s); u32x2* o = (u32x2*)((bf16*)(ws + WS_MEMB) + (size_t)m * D) + lane;
#pragma unroll
            for (int j = 0; j < 4; ++j) { u32x2 w; w.x = pk2(v[j][0], v[j][1]); w.y = pk2(v[j][2], v[j][3]); o[64 * j] = w; }
            if (lane == 0) ((float*)(ws + WS_MEMRS))[m] = rsqrtf(s * (1.f / 1024.f) + EPS); }
        for (int m = gw; m < S; m += NGW) { const f32x4* xr = (const f32x4*)(argin(0) + (size_t)m * D) + lane; float s = 0.f; f32x4 v[4];
#pragma unroll
            for (int j = 0; j < 4; ++j) { v[j] = xr[64 * j]; s += (v[j][0] * v[j][0] + v[j][1] * v[j][1]) + (v[j][2] * v[j][2] + v[j][3] * v[j][3]); }
            s = wave_sum(s); u32x2* o = (u32x2*)(XB + (size_t)m * D) + lane;
#pragma unroll
            for (int j = 0; j < 4; ++j) { u32x2 w; w.x = pk2(v[j][0], v[j][1]); w.y = pk2(v[j][2], v[j][3]); o[64 * j] = w; }
            if (lane < 16) SSQ[(size_t)m * 16 + lane] = lane == 0 ? s : 0.f; }
    }
    { PH_VARS layer_weights(0, 1 | 4, gw, NGW, scr, lane); }
    if (G == 0x7fffffff) grid.sync();
    GSYNC(); STAMP();
    for (int l = 0; l < 2; ++l) {
        { PH_VARS pg8::TileSched Sd; Sd.init(S, 2 * FF, G, bx, XB, D, ws + WS_F1IN, D); pg8::EpiSwiGLU E{(bf16*)(ws + WS_BIG), SSQ, (LAS float*)(lds + RED_OFF)}; pg8::rs_prefill(Sd, SSQ, (LAS float*)(lds + RED_OFF)); pg8::gemm_phase(lds, D, D, D, Sd, E); }
        if (l == 0) { PH_VARS pg8::KvSched Sd{G, (bx + G - G / 2) % G, ws}; pg8::EpiPrep<0> E{ws}; pg8::gemm_phase(lds, 1024, 1024, 1024, Sd, E); }
        if (bx >= G / 2) { PH_VARS layer_weights(l, 2, (bx - G / 2) * 8 + wave, (G - G / 2) * 8, scr, lane); }
        GSYNC(); STAMP();
        { PH_VARS pg8::TileSched Sd; Sd.init(S, D, G, bx, ws + WS_BIG, FF, ws + WS_F1OUT, FF); pg8::EpiResid E{X, XB, SSQ, 0.5f, l == 0 ? argin(0) : (const float*)X}; pg8::gemm_phase(lds, FF, FF, FF, Sd, E); }
        GSYNC(); STAMP();
        if (l == 0) {
            { PH_VARS pg8::TileSched Sd; Sd.init(S, ABN, G, bx, XB, D, ws + WS_MIXIN, D); pg8::EpiBf16 E{(bf16*)(ws + WS_BIG), ABN, SSQ, 1, 1.f, (LAS float*)(lds + RED_OFF)}; pg8::rs_prefill(Sd, SSQ, (LAS float*)(lds + RED_OFF)); pg8::gemm_phase(lds, D, D, D, Sd, E); }
            { PH_VARS pg8::QkSched Sd{G, (bx + G - G / 2) % G, ws}; pg8::EpiPrep<1> E{ws}; pg8::gemm_phase(lds, 2048, 1024, 256, Sd, E); }
            { PH_VARS pg8::VoSched Sd{G, (bx + G - G / 2 - 32) % G, ws}; pg8::EpiPrep<2> E{ws}; pg8::gemm_phase(lds, 1024, 2048, 256, Sd, E); }
            if (bx >= G / 2) { PH_VARS layer_weights(1, 1, (bx - G / 2) * 8 + wave, (G - G / 2) * 8, scr, lane); }
            GSYNC(); STAMP();
#ifndef NO_LRU
            for (int u = bx; u < 2048; u += G) lru_local_unit((LAS float*)lds, u, u == bx || (G & 7) != 0);
#endif
            __syncthreads(); STAMP();
#ifndef NO_ATTN
            { PH_VARS for (int u = gw; u < 4096; u += NGW) attn_unit2((const bf16*)(ws + WS_BIG), OB, lds + wave * 9216, u, u + 4096, lane); }
#endif
            GSYNC(); STAMP();
#ifndef NO_LRU
            lru_apply_wg((LAS float*)lds, bx, G);
#endif
            GSYNC(); STAMP();
        } else {
            { PH_VARS pg8::TileSched Sd; Sd.init(S, 4096, G, bx, XB, D, ws + WS_MIXIN, D);
              pg8::EpiDN E{(bf16*)(ws + WS_BIG), (bf16*)(ws + WS_BIG + 96 * MiB), (bf16*)(ws + WS_HALO), (float*)(ws + WS_DNAB), SSQ, argin(25), argin(26), (LAS float*)(lds + RED_OFF)}; pg8::rs_prefill(Sd, SSQ, (LAS float*)(lds + RED_OFF)); pg8::gemm_phase(lds, D, D, D, Sd, E); }
            {   PH_VARS
                const bf16* Wab = (const bf16*)(ws + WS_MIXIN) + (size_t)4096 * D; float* AB = (float*)(ws + WS_DNAB);
                const float* a_log = argin(25); const float* dt_bias = argin(26);
                const int c = lane & 15, q = lane >> 4;
                for (int rb = gw; rb < S / 16; rb += NGW) {
                    const bf16* ap = XB + (size_t)(rb * 16 + c) * D + 8 * q; const bf16* bp = Wab + (size_t)c * D + 8 * q;
                    f32x4 acc = (f32x4){0.f, 0.f, 0.f, 0.f};
#pragma unroll 8
                    for (int ks = 0; ks < 32; ++ks) acc = MFMA16(*(const bf16x8*)(ap + 32 * ks), *(const bf16x8*)(bp + 32 * ks), acc);
                    const int h = c & 7; const float al = -__expf(a_log[h]), db = dt_bias[h];
#pragma unroll
                    for (int e = 0; e < 4; ++e) { const int row = rb * 16 + 4 * q + e; const float v = acc[e] * row_rstd16(SSQ, row);
                        AB[(size_t)row * 16 + c] = (c < 8) ? al * softplusf_(v + db) : sigmoidf_(v); } }
            }
            GSYNC(); STAMP();
            f32x4 dnS[2]; dnS[0] = (f32x4){0.f, 0.f, 0.f, 0.f}; dnS[1] = dnS[0];
            for (int u = bx; u < 512; u += G) dn_local_unit(lds, u);
            GSYNC(); STAMP();
            for (int k = 1; k <= 4; ++k) {
                if (bx < 64) dn_scan_worker(lds, ((bx & 7) << 3) | (bx >> 3), 64 * (k - 1), 64 * k, dnS);
                else if (k < 4) { for (int u = 512 * k + (bx - 64); u < 512 * (k + 1); u += G - 64) dn_local_unit(lds, u); }
                else { PH_VARS const int w = (bx - 64) * 8 + wave, nw = (G - 64) * 8;
                    dn_gate_rows(0, 6144, w, nw, lane); dn_gate_rows(8192, 12288, w, nw, lane); }
                GSYNC();
            }
            STAMP();
            {   PH_VARS
                dn_gate_rows(6144, 8192, gw, NGW, lane); dn_gate_rows(12288, S, gw, NGW, lane);
            }
            GSYNC(); STAMP();
        }
        { PH_VARS pg8::TileSched Sd; Sd.init(S, D, G, bx, OB, D, ws + WS_MIXOUT, D); pg8::EpiResid E{X, XB, SSQ, 1.0f, X}; pg8::gemm_phase(lds, D, D, D, Sd, E); }
        GSYNC(); STAMP();
        { PH_VARS pg8::TileSched Sd; Sd.init(S, D, G, bx, XB, D, ws + WS_WQK + (size_t)l * 2 * MiB, D); pg8::EpiSoftmax E{(bf16*)(ws + WS_BIG), SSQ, (LAS float*)(lds + RED_OFF)}; pg8::gemm_phase(lds, D, D, D, Sd, E); }
        GSYNC(); STAMP();
        { PH_VARS pg8::TileSched Sd; Sd.init(S, D, G, bx, ws + WS_BIG, D, ws + WS_WVO + (size_t)l * 2 * MiB, D); pg8::EpiResid E{X, XB, SSQ, 1.0f, X}; pg8::gemm_phase(lds, D, D, D, Sd, E); }
        GSYNC(); STAMP();
        { PH_VARS pg8::TileSched Sd; Sd.init(S, 2 * FF, G, bx, XB, D, ws + WS_F2IN, D); pg8::EpiSwiGLU E{(bf16*)(ws + WS_BIG), SSQ, (LAS float*)(lds + RED_OFF)}; pg8::rs_prefill(Sd, SSQ, (LAS float*)(lds + RED_OFF)); pg8::gemm_phase(lds, D, D, D, Sd, E); }
        if (l == 0 && bx >= G / 2) { PH_VARS layer_weights(1, 4, (bx - G / 2) * 8 + wave, (G - G / 2) * 8, scr, lane); }
        GSYNC(); STAMP();
        { PH_VARS pg8::TileSched Sd; Sd.init(S, D, G, bx, ws + WS_BIG, FF, ws + WS_F2OUT, FF); pg8::EpiResid E{X, XB, SSQ, 0.5f, X}; pg8::gemm_phase(lds, FF, FF, FF, Sd, E); }
        GSYNC(); STAMP();
    }
    { PH_VARS const float* gf = argin(29);
      for (int m = gw; m < S; m += NGW) { const float rs = row_rstd16(SSQ, m); f32x4* xr = (f32x4*)(X + (size_t)m * D) + lane; const f32x4* gp = (const f32x4*)gf + lane;
#pragma unroll
          for (int j = 0; j < 4; ++j) { const f32x4 v = xr[64 * j], g = gp[64 * j]; xr[64 * j] = v * rs * g; } } }
#ifdef EXFIL_A
    STAMP();
    {
        const unsigned long long* st = (const unsigned long long*)argws();
        if (bx == 0) { const unsigned long long dt = st[EXFIL_B] - st[EXFIL_A]; const unsigned long long t0 = __builtin_amdgcn_s_memrealtime();
            while (__builtin_amdgcn_s_memrealtime() - t0 < 4ull * dt) __builtin_amdgcn_s_sleep(32); }
    }
#endif
}

extern "C" void kernel_launch(void* const* d_in, const int* in_sizes, int n_in, void* d_out, int out_size, void* d_ws, size_t ws_size, hipStream_t stream) {
    static int grid = 0;
    if (grid == 0) {
        if (n_in != 30 || out_size != S * D || ws_size < WS_END) { fprintf(stderr, "kernel_launch: unexpected shapes (n_in %d out %d ws %zu)\n", n_in, out_size, ws_size); grid = -1; return; }
        int dev = 0, cus = 0, per_cu = 0;
        hipGetDevice(&dev); hipDeviceGetAttribute(&cus, hipDeviceAttributeMultiprocessorCount, dev);
        hipFuncSetAttribute((const void*)mk_fwd, hipFuncAttributeMaxDynamicSharedMemorySize, LDS_BYTES);
        hipOccupancyMaxActiveBlocksPerMultiprocessor(&per_cu, (const void*)mk_fwd, 512, LDS_BYTES);
        if (per_cu < 1) { fprintf(stderr, "kernel_launch: occupancy query says %d blocks per CU\n", per_cu); per_cu = 1; }
        grid = (cus / 8) * 8;
        (void)hipGetLastError();
    }
    if (grid < 0) return;
    if (hipMemsetAsync((char*)d_ws + WS_BAR, 0, 16384, stream) != hipSuccess) { fprintf(stderr, "kernel_launch: memset failed\n"); return; }
    Args a{};
    for (int i = 0; i < 30; ++i) a.in[i] = (const float*)d_in[i];
    a.out = (float*)d_out; a.ws = (unsigned char*)d_ws;
    void* args[] = {&a};
    hipError_t e = hipLaunchCooperativeKernel((const void*)mk_fwd, dim3(grid), dim3(512), args, LDS_BYTES, stream);
    if (e != hipSuccess) fprintf(stderr, "cooperative launch failed: %s (grid %d)\n", hipGetErrorString(e), grid);
}
```
